# Optimizing an MI355X kernel written in HIP

```python
import jax, jax.numpy as jnp
from jax import lax
import numpy as np

D_MODEL = 2048
BATCH = 4
SEQ = 2048
DEPTH = 1
DEC_BATCH = 128
DEC_SEQ = 1
PAST_LEN = 16384
PAGE_SIZE = 128

ML_HEADS = 4
ML_WIDTH = D_MODEL
ML_DV = ML_WIDTH // ML_HEADS
ML_DK = ML_DV // 2
ML_QK = ML_HEADS * ML_DK
SSM_WIDTH = D_MODEL
SSM_HEADDIM = 64
SSM_HEADS = SSM_WIDTH // SSM_HEADDIM
SSM_GROUPS = 2
SSM_STATE = 128
CONV_W = 4
XBC_DIM = SSM_WIDTH + 2 * SSM_GROUPS * SSM_STATE
D_FF = 5632
IN_DIM = 2 * ML_QK + ML_WIDTH + 2 * ML_HEADS + ML_WIDTH + SSM_WIDTH + XBC_DIM + SSM_HEADS + 2 * D_MODEL
CHUNK = 128
EPS = 1e-6
NEG_INIT = -1e30

kernel_name = "hybrid_mlstm_ssd_macaron_step"


def _rms(x):
    xf = x.astype(jnp.float32)
    return xf * lax.rsqrt(jnp.mean(xf * xf, axis=-1, keepdims=True) + EPS)


def rmsnorm(x, w):
    return (_rms(x) * w.astype(jnp.float32)).astype(x.dtype)


def swiglu(x, w_gate, w_up, w_down):
    return (jax.nn.silu(x @ w_gate) * (x @ w_up)) @ w_down


def _chunking(L):
    c = CHUNK if L % CHUNK == 0 else L
    return L // c, c


def causal_conv(xbc, conv_state, w, b):
    L = xbc.shape[1]
    xp = jnp.concatenate([conv_state.astype(xbc.dtype), xbc], axis=1)
    y = sum(xp[:, j:j + L] * w[j] for j in range(CONV_W)) + b
    return jax.nn.silu(y), xp[:, -(CONV_W - 1):]


def mlstm_chunked(q, k, v, li, lf, C0, n0, m0):
    Bsz, L, H, _ = q.shape
    DV = v.shape[-1]
    nc, c = _chunking(L)

    def to_chunks(t):
        t = t.reshape((Bsz, nc, c) + t.shape[2:])
        return jnp.moveaxis(jnp.moveaxis(t, 1, 0), 3, 2)

    causal = jnp.tril(jnp.ones((c, c), dtype=bool))

    def step(carry, inp):
        C, n, m = carry
        qc, kc, vc, lic, lfc = inp
        b = jnp.cumsum(lfc, axis=-1)
        dmat = jnp.where(causal, b[..., :, None] - b[..., None, :] + lic[..., None, :], -jnp.inf)
        inter = b + m[..., None]
        m_t = jnp.maximum(inter, dmat.max(-1))
        w_intra = jnp.exp(dmat - m_t[..., None])
        w_inter = jnp.exp(inter - m_t)
        s = jnp.einsum('bhtd,bhsd->bhts', qc, kc) * w_intra
        num = jnp.einsum('bhts,bhsv->bhtv', s, vc) + w_inter[..., None] * jnp.einsum('bhtd,bhdv->bhtv', qc, C)
        den = s.sum(-1) + w_inter * jnp.einsum('bhtd,bhd->bht', qc, n)
        h = num / jnp.maximum(jnp.abs(den), jnp.exp(-m_t))[..., None]
        m_new = m_t[..., -1]
        w_end = jnp.exp(b[..., -1:] - b + lic - m_new[..., None])
        decay = jnp.exp(b[..., -1] + m - m_new)
        kw = kc * w_end[..., None]
        C_new = decay[..., None, None] * C + jnp.einsum('bhsd,bhsv->bhdv', kw, vc)
        n_new = decay[..., None] * n + kw.sum(-2)
        return (C_new, n_new, m_new), h

    (C1, n1, m1), hs = lax.scan(step, (C0, n0, m0), (to_chunks(q), to_chunks(k), to_chunks(v), to_chunks(li), to_chunks(lf)))
    hs = jnp.swapaxes(jnp.moveaxis(hs, 0, 1), 2, 3).reshape(Bsz, L, H, DV)
    return hs, C1, n1, m1


def ssd_chunked(x, dt, A, Bm, Cm, S0):
    Bsz, L, H, P = x.shape
    G, N = Bm.shape[2], Bm.shape[3]
    R = H // G
    nc, c = _chunking(L)
    xg = x.reshape(Bsz, nc, c, G, R, P).transpose(1, 0, 3, 4, 2, 5)
    dtg = dt.reshape(Bsz, nc, c, G, R).transpose(1, 0, 3, 4, 2)
    ag = dtg * A.reshape(G, R)[None, None, :, :, None]
    Bg = Bm.reshape(Bsz, nc, c, G, N).transpose(1, 0, 3, 2, 4)
    Cg = Cm.reshape(Bsz, nc, c, G, N).transpose(1, 0, 3, 2, 4)
    causal = jnp.tril(jnp.ones((c, c), dtype=bool))

    def step(S, inp):
        xc, dtc, ac, Bc, Cc = inp
        b = jnp.cumsum(ac, axis=-1)
        decay = jnp.exp(jnp.where(causal, b[..., :, None] - b[..., None, :], -jnp.inf))
        cb = jnp.einsum('bgtn,bgsn->bgts', Cc, Bc)
        M = cb[:, :, None] * decay * dtc[..., None, :]
        y = jnp.einsum('bgrts,bgrsp->bgrtp', M, xc) + jnp.exp(b)[..., None] * jnp.einsum('bgtn,bgrpn->bgrtp', Cc, S)
        w_end = jnp.exp(b[..., -1:] - b) * dtc
        S_new = jnp.exp(b[..., -1])[..., None, None] * S + jnp.einsum('bgrs,bgrsp,bgsn->bgrpn', w_end, xc, Bc)
        return S_new, y

    S1, ys = lax.scan(step, S0.reshape(Bsz, G, R, P, N), (xg, dtg, ag, Bg, Cg))
    ys = ys.transpose(1, 0, 4, 2, 3, 5).reshape(Bsz, L, H, P)
    return ys, S1.reshape(Bsz, H, P, N)


def token_mixer(u, conv_st, C0, n0, m0, S0, w_in, ml_i_bias, ml_f_bias, ml_head_norm,
                conv_w, conv_b, dt_bias, A_log, D_skip, ssm_norm, w_out):
    Bsz, L, _ = u.shape
    f32 = jnp.float32
    proj = u @ w_in
    sizes = [ML_QK, ML_QK, ML_WIDTH, ML_HEADS, ML_HEADS, ML_WIDTH, SSM_WIDTH, XBC_DIM, SSM_HEADS, 2 * D_MODEL]
    idx = [int(s) for s in np.cumsum(sizes)[:-1]]
    q, k, v, ig, fg, og, z, xbc, dt_raw, gates = jnp.split(proj, idx, axis=-1)
    q = q.astype(f32).reshape(Bsz, L, ML_HEADS, ML_DK) * (ML_DK ** -0.5)
    k = k.astype(f32).reshape(Bsz, L, ML_HEADS, ML_DK)
    v = v.astype(f32).reshape(Bsz, L, ML_HEADS, ML_DV)
    li = (ig + ml_i_bias).astype(f32)
    lf = jax.nn.log_sigmoid((fg + ml_f_bias).astype(f32))
    h_ml, C1, n1, m1 = mlstm_chunked(q, k, v, li, lf, C0.astype(f32), n0.astype(f32), m0.astype(f32))
    h_ml = (_rms(h_ml) * ml_head_norm.astype(f32).reshape(ML_HEADS, ML_DV)).reshape(Bsz, L, ML_WIDTH)
    y_a = jax.nn.sigmoid(og.astype(f32)) * h_ml
    xbc_act, conv_new = causal_conv(xbc, conv_st, conv_w, conv_b)
    xs, Bm, Cm = jnp.split(xbc_act.astype(f32), [SSM_WIDTH, SSM_WIDTH + SSM_GROUPS * SSM_STATE], axis=-1)
    xs = xs.reshape(Bsz, L, SSM_HEADS, SSM_HEADDIM)
    Bm = Bm.reshape(Bsz, L, SSM_GROUPS, SSM_STATE)
    Cm = Cm.reshape(Bsz, L, SSM_GROUPS, SSM_STATE)
    dt = jax.nn.softplus((dt_raw + dt_bias).astype(f32))
    A = -jnp.exp(A_log.astype(f32))
    y_s, S1 = ssd_chunked(xs, dt, A, Bm, Cm, S0.astype(f32))
    y_s = (y_s + D_skip.astype(f32)[:, None] * xs).reshape(Bsz, L, SSM_WIDTH)
    y_s = y_s * jax.nn.silu(z.astype(f32))
    y_b = _rms(y_s.reshape(Bsz, L, SSM_GROUPS, SSM_WIDTH // SSM_GROUPS)).reshape(Bsz, L, SSM_WIDTH) * ssm_norm.astype(f32)
    g = jax.nn.sigmoid(gates.astype(f32))
    merged = g[..., :D_MODEL] * y_a + g[..., D_MODEL:] * y_b
    out = merged.astype(u.dtype) @ w_out
    return out, conv_new, C1, n1, m1, S1


def trunk_layer(x, conv_st, C0, n0, m0, S0,
                ffn1_norm, ffn1_w_gate, ffn1_w_up, ffn1_w_down, mix_norm, w_in, ml_i_bias, ml_f_bias,
                ml_head_norm, conv_w, conv_b, dt_bias, A_log, D_skip, ssm_norm, w_out,
                ffn2_norm, ffn2_w_gate, ffn2_w_up, ffn2_w_down):
    x = x + 0.5 * swiglu(rmsnorm(x, ffn1_norm), ffn1_w_gate, ffn1_w_up, ffn1_w_down)
    mix, conv_new, C1, n1, m1, S1 = token_mixer(rmsnorm(x, mix_norm), conv_st, C0, n0, m0, S0, w_in,
                                                ml_i_bias, ml_f_bias, ml_head_norm, conv_w, conv_b,
                                                dt_bias, A_log, D_skip, ssm_norm, w_out)
    x = x + mix
    x = x + 0.5 * swiglu(rmsnorm(x, ffn2_norm), ffn2_w_gate, ffn2_w_up, ffn2_w_down)
    return x, conv_new, C1, n1, m1, S1


def setup_inputs(seed: int = 0) -> dict:
    key = jax.random.key(seed)
    ks = jax.random.split(key, 32)
    nrm = jax.random.normal
    f32 = jnp.float32
    dt0 = jnp.exp(jax.random.uniform(ks[20], (DEPTH, SSM_HEADS)) * (np.log(0.1) - np.log(0.001)) + np.log(0.001))
    return {
        "x_prompt": nrm(ks[0], (BATCH, SEQ, D_MODEL), f32),
        "x_sample": nrm(ks[1], (DEC_BATCH, DEC_SEQ, D_MODEL), f32),
        "state_conv": nrm(ks[2], (DEPTH, DEC_BATCH, CONV_W - 1, XBC_DIM), f32),
        "state_mlstm_C": 0.5 * nrm(ks[3], (DEPTH, DEC_BATCH, ML_HEADS, ML_DK, ML_DV), f32),
        "state_mlstm_n": 0.5 * nrm(ks[4], (DEPTH, DEC_BATCH, ML_HEADS, ML_DK), f32),
        "state_mlstm_m": nrm(ks[5], (DEPTH, DEC_BATCH, ML_HEADS), f32),
        "state_ssm": 0.5 * nrm(ks[6], (DEPTH, DEC_BATCH, SSM_HEADS, SSM_HEADDIM, SSM_STATE), f32),
        "ffn1_norm": 1.0 + 0.02 * nrm(ks[7], (DEPTH, D_MODEL), f32),
        "ffn1_w_gate": nrm(ks[8], (DEPTH, D_MODEL, D_FF), f32) * D_MODEL ** -0.5,
        "ffn1_w_up": nrm(ks[9], (DEPTH, D_MODEL, D_FF), f32) * D_MODEL ** -0.5,
        "ffn1_w_down": nrm(ks[10], (DEPTH, D_FF, D_MODEL), f32) * D_FF ** -0.5,
        "mix_norm": 1.0 + 0.02 * nrm(ks[11], (DEPTH, D_MODEL), f32),
        "w_in": nrm(ks[12], (DEPTH, D_MODEL, IN_DIM), f32) * D_MODEL ** -0.5,
        "ml_i_bias": 0.1 * nrm(ks[13], (DEPTH, ML_HEADS), f32),
        "ml_f_bias": jax.random.uniform(ks[14], (DEPTH, ML_HEADS), f32, 3.0, 6.0),
        "ml_head_norm": 1.0 + 0.02 * nrm(ks[15], (DEPTH, ML_WIDTH), f32),
        "ssm_conv_w": 0.5 * nrm(ks[16], (DEPTH, CONV_W, XBC_DIM), f32),
        "ssm_conv_b": 0.02 * nrm(ks[17], (DEPTH, XBC_DIM), f32),
        "ssm_dt_bias": (dt0 + jnp.log(-jnp.expm1(-dt0))).astype(f32),
        "ssm_A_log": jnp.log(jax.random.uniform(ks[18], (DEPTH, SSM_HEADS), f32, 1.0, 16.0)),
        "ssm_D": 1.0 + 0.1 * nrm(ks[19], (DEPTH, SSM_HEADS), f32),
        "ssm_norm": 1.0 + 0.02 * nrm(ks[21], (DEPTH, SSM_WIDTH), f32),
        "w_out": nrm(ks[22], (DEPTH, D_MODEL, D_MODEL), f32) * D_MODEL ** -0.5,
        "ffn2_norm": 1.0 + 0.02 * nrm(ks[23], (DEPTH, D_MODEL), f32),
        "ffn2_w_gate": nrm(ks[24], (DEPTH, D_MODEL, D_FF), f32) * D_MODEL ** -0.5,
        "ffn2_w_up": nrm(ks[25], (DEPTH, D_MODEL, D_FF), f32) * D_MODEL ** -0.5,
        "ffn2_w_down": nrm(ks[26], (DEPTH, D_FF, D_MODEL), f32) * D_FF ** -0.5,
        "final_norm": 1.0 + 0.02 * nrm(ks[27], (D_MODEL,), f32),
    }


def reference(x_prompt, x_sample, state_conv, state_mlstm_C, state_mlstm_n, state_mlstm_m, state_ssm,
              ffn1_norm, ffn1_w_gate, ffn1_w_up, ffn1_w_down, mix_norm, w_in, ml_i_bias, ml_f_bias,
              ml_head_norm, ssm_conv_w, ssm_conv_b, ssm_dt_bias, ssm_A_log, ssm_D, ssm_norm, w_out,
              ffn2_norm, ffn2_w_gate, ffn2_w_up, ffn2_w_down, final_norm):
    f32 = jnp.float32
    Bp = x_prompt.shape[0]
    p_st = (jnp.zeros((Bp, CONV_W - 1, XBC_DIM), x_prompt.dtype),
            jnp.zeros((Bp, ML_HEADS, ML_DK, ML_DV), f32),
            jnp.zeros((Bp, ML_HEADS, ML_DK), f32),
            jnp.full((Bp, ML_HEADS), NEG_INIT, f32),
            jnp.zeros((Bp, SSM_HEADS, SSM_HEADDIM, SSM_STATE), f32))
    xp, xs = x_prompt, x_sample
    pc, pC, pn, pm, pS = [], [], [], [], []
    sc, sC, sn, sm, sS = [], [], [], [], []
    for l in range(DEPTH):
        w = (ffn1_norm[l], ffn1_w_gate[l], ffn1_w_up[l], ffn1_w_down[l], mix_norm[l], w_in[l],
             ml_i_bias[l], ml_f_bias[l], ml_head_norm[l], ssm_conv_w[l], ssm_conv_b[l], ssm_dt_bias[l],
             ssm_A_log[l], ssm_D[l], ssm_norm[l], w_out[l], ffn2_norm[l], ffn2_w_gate[l], ffn2_w_up[l],
             ffn2_w_down[l])
        xp, c1, C1, n1, m1, S1 = trunk_layer(xp, *p_st, *w)
        pc.append(c1); pC.append(C1); pn.append(n1); pm.append(m1); pS.append(S1)
        xs, c2, C2, n2, m2, S2 = trunk_layer(xs, state_conv[l], state_mlstm_C[l], state_mlstm_n[l],
                                             state_mlstm_m[l], state_ssm[l], *w)
        sc.append(c2); sC.append(C2); sn.append(n2); sm.append(m2); sS.append(S2)
    y_prompt = rmsnorm(xp, final_norm)
    y_sample = rmsnorm(xs, final_norm)
    return (y_prompt, y_sample,
            jnp.stack(pc), jnp.stack(pC), jnp.stack(pn), jnp.stack(pm), jnp.stack(pS),
            jnp.stack(sc), jnp.stack(sC), jnp.stack(sn), jnp.stack(sm), jnp.stack(sS))
```

```cpp
#include <hip/hip_runtime.h>
#include <hip/hip_cooperative_groups.h>
#include <cstdio>
#include <cstdint>
namespace cg = cooperative_groups;
#define DI __device__ __forceinline__
namespace pg8 {
#define PG8_LAS __attribute__((address_space(3)))
typedef unsigned short bf16_t;
typedef short bf16x8 __attribute__((ext_vector_type(8)));
typedef float f32x4 __attribute__((ext_vector_type(4)));
typedef unsigned u32x4 __attribute__((ext_vector_type(4)));
constexpr int BM = 256, BK = 64, HALF = 128, HTB = HALF * BK * 2  , STAGE_BYTES = 8 * HTB, NXCD = 8, WGM = 8;

__host__ __device__ __forceinline__ int lds_byte(int r, int c) { const int st = (r >> 4) * 2 + (c >> 5), rr = r & 15, cc = c & 31, ob = rr * 64 + cc * 2; return st * 1024 + (ob ^ (((ob >> 9) & 1) << 5)); }
__host__ __device__ __forceinline__ void stage_rc(int b, int& R, int& C) { const int st = b / 1024, sb = b % 1024, swz = sb ^ (((sb >> 9) & 1) << 5); R = (st >> 1) * 16 + swz / 64; C = (st & 1) * 32 + (swz % 64) / 2; }
__host__ __device__ __forceinline__ int perm32(int rho) { const int n = rho >> 4, i = rho & 15; return 8 * (i >> 2) + 4 * n + (i & 3); }

struct Unit { int pm, pn; };
struct Gemm { const bf16_t* A; const bf16_t* Bt; int M, N, K; };

struct StaticOrder {
    int nM, nN, nwg, G, c;
    __host__ __device__ void init(int M, int N, int G_, int c_) { nM = M / BM; nN = N / BM; nwg = nM * nN; G = G_; c = c_; }
    __host__ __device__ bool next(int i, Unit& u) const {
        const long L = (long)i * G + c; if (L >= nwg) return false;
        int wgid = (int)L; { const int q = nwg / NXCD, r = nwg % NXCD, xcd = wgid % NXCD, off = wgid / NXCD; wgid = (xcd < r ? xcd * (q + 1) : r * (q + 1) + (xcd - r) * q) + off; }
        const int nig = WGM * nN, gid = wgid / nig, fm = gid * WGM, gsz = (nM - fm) < WGM ? (nM - fm) : WGM;
        u.pm = fm + ((wgid % nig) % gsz); u.pn = (wgid % nig) / gsz; return true;
    }
    __device__ __forceinline__ void a_ready(const Unit&) const {}
    __device__ __forceinline__ void done(const Unit&) const {}
};

typedef unsigned u32x2 __attribute__((ext_vector_type(2)));
__device__ __forceinline__ unsigned pk_bf16(float lo, float hi) {
    typedef __bf16 bfx2 __attribute__((ext_vector_type(2))); typedef float fx2 __attribute__((ext_vector_type(2)));
    fx2 v = {lo, hi}; return __builtin_bit_cast(unsigned, __builtin_convertvector(v, bfx2));
}
constexpr float SSQ_SCALE = 4294967296.0f;
__device__ __forceinline__ float rs_from(const unsigned long long* ssq, int row, float inv_n) { return rsqrtf((float)ssq[row] * (inv_n / SSQ_SCALE) + 1e-6f); }
__device__ __forceinline__ float silu_f(float g) { return g * __builtin_amdgcn_rcpf(1.0f + __expf(-g)); }
__device__ __forceinline__ float sigm_f(float g) { return __builtin_amdgcn_rcpf(1.0f + __expf(-g)); }

struct EpiSwiGLU {
    static constexpr bool PERM = true, AFTER_DRAIN = false;
    bf16_t* H; int ldh; const unsigned long long* ssq;
    __device__ __forceinline__ void operator()(const f32x4 (&acc)[2][2][4][2], const Unit& u, int wr, int wc, int fr, int fq) const {
        const int row0 = u.pm * BM + wr * 64 + fr, col0 = u.pn * HALF + wc * 32 + 8 * fq;
#pragma unroll
        for (int ai = 0; ai < 2; ++ai)
#pragma unroll
            for (int m = 0; m < 4; ++m) {
                const int row = row0 + ai * HALF + m * 16; const float r = rs_from(ssq, row, 1.0f / 2048.0f);
                float hv[8];
#pragma unroll
                for (int n = 0; n < 2; ++n)
#pragma unroll
                    for (int i = 0; i < 4; ++i) { const float g = acc[ai][0][m][n][i] * r, up = acc[ai][1][m][n][i] * r; hv[4 * n + i] = silu_f(g) * up; }
                u32x4 w; w.x = pk_bf16(hv[0], hv[1]); w.y = pk_bf16(hv[2], hv[3]); w.z = pk_bf16(hv[4], hv[5]); w.w = pk_bf16(hv[6], hv[7]);
                *(u32x4*)(H + (size_t)row * ldh + col0) = w;
            }
    }
};
struct EpiResid {
    static constexpr bool PERM = false, AFTER_DRAIN = false;
    const float* res0; const bf16_t* resb; float* out; bf16_t* xb; unsigned long long* ssq; float alpha;
    __device__ __forceinline__ void operator()(const f32x4 (&acc)[2][2][4][2], const Unit& u, int wr, int wc, int fr, int fq) const {
        const int row0 = u.pm * BM + wr * 64 + fr, col0 = u.pn * BM + wc * 32 + 4 * fq;
#pragma unroll
        for (int ai = 0; ai < 2; ++ai)
#pragma unroll
            for (int m = 0; m < 4; ++m) {
                const int row = row0 + ai * HALF + m * 16;
                float ss = 0.f;
#pragma unroll
                for (int bj = 0; bj < 2; ++bj)
#pragma unroll
                    for (int n = 0; n < 2; ++n) {
                        const size_t off = (size_t)row * 2048 + col0 + bj * HALF + n * 16;
                        f32x4 rv;
                        if (res0) rv = *(const f32x4*)(res0 + off);
                        else { const u32x2 rw = *(const u32x2*)(resb + off); rv = (f32x4){__uint_as_float(rw.x << 16), __uint_as_float(rw.x & 0xffff0000u), __uint_as_float(rw.y << 16), __uint_as_float(rw.y & 0xffff0000u)}; }
                        const f32x4 o = rv + acc[ai][bj][m][n] * alpha;
                        ss += (o[0] * o[0] + o[1] * o[1]) + (o[2] * o[2] + o[3] * o[3]);
                        if (out) *(f32x4*)(out + off) = o;
                        if (xb) { u32x2 w; w.x = pk_bf16(o[0], o[1]); w.y = pk_bf16(o[2], o[3]); *(u32x2*)(xb + off) = w; }
                    }
                ss += __shfl_xor(ss, 16); ss += __shfl_xor(ss, 32);
                if (fq == 0) atomicAdd(ssq + row, (unsigned long long)(ss * SSQ_SCALE));
            }
    }
};
struct EpiProj {
    static constexpr bool PERM = true, AFTER_DRAIN = false;
    bf16_t* P; int ldp; float* gsm; const unsigned long long* ssq; int n_main;
    __device__ __forceinline__ void operator()(const f32x4 (&acc)[2][2][4][2], const Unit& u, int wr, int wc, int fr, int fq) const {
        const int row0 = u.pm * BM + wr * 64 + fr;
#pragma unroll
        for (int ai = 0; ai < 2; ++ai)
#pragma unroll
            for (int m = 0; m < 4; ++m) {
                const int row = row0 + ai * HALF + m * 16; const float r = rs_from(ssq, row, 1.0f / 2048.0f);
                if (u.pn < n_main) {
                    const int col0 = u.pn * BM + wc * 32 + 8 * fq;
#pragma unroll
                    for (int bj = 0; bj < 2; ++bj) { const f32x4 v0 = acc[ai][bj][m][0] * r, v1 = acc[ai][bj][m][1] * r;
                        u32x4 w; w.x = pk_bf16(v0[0], v0[1]); w.y = pk_bf16(v0[2], v0[3]); w.z = pk_bf16(v1[0], v1[1]); w.w = pk_bf16(v1[2], v1[3]);
                        *(u32x4*)(P + (size_t)row * ldp + col0 + bj * HALF) = w; }
                } else if (wc < 2) {
                    float* gp = gsm + (size_t)row * 64 + wc * 32 + 8 * fq;
                    *(f32x4*)gp = acc[ai][0][m][0] * r; *(f32x4*)(gp + 4) = acc[ai][0][m][1] * r;
                }
            }
    }
};

template <class Epi, class Sched, bool ALIGN_EPI = false, bool SP2 = false>
__device__ __forceinline__ void gemm_phase(PG8_LAS unsigned char* lds, const Gemm g, const Sched& S, const Epi& E) {
    int tid_ = threadIdx.x; asm volatile("" : "+v"(tid_)); const int tid = tid_, wid = __builtin_amdgcn_readfirstlane(tid >> 6), lane = tid & 63, wr = wid >> 2, wc = wid & 3, fr = lane & 15, fq = lane >> 4;
    const int K = g.K, nt = K / BK;
    unsigned voffA[2], voffB[2];
#pragma unroll
    for (int i = 0; i < 2; ++i) { int R, C; stage_rc(tid * 16 + i * 8192, R, C); const int Rb = Epi::PERM ? ((R & ~31) + perm32(R & 31)) : R;
        voffA[i] = (unsigned)(R * K + C) * 2u; voffB[i] = (unsigned)(Rb * K + C) * 2u; }
    const size_t kstep = (size_t)(BK * 2);
    const size_t hstep = (size_t)HALF * K * 2;
    const size_t tstep = 2 * hstep;
    const unsigned ldsw = (unsigned)wid * 1024u;
    const int aoff = lds_byte(wr * 64 + fr, fq * 8), boff = lds_byte(wc * 32 + fr, fq * 8);
#define PG8_SA(b, h) (((b) * 2 + (h)) * HTB)
#define PG8_SB(b, h) ((4 + (b) * 2 + (h)) * HTB)
#define PG8_STAGE(bufoff, gbase, voff) do { _Pragma("unroll") for (int _i = 0; _i < 2; ++_i) \
        __builtin_amdgcn_global_load_lds((const unsigned*)((const char*)(gbase) + (voff)[_i]), (PG8_LAS unsigned*)(lds + (bufoff) + ldsw + _i * 8192), 16, 0, 0); } while (0)
#define PG8_LDA(dst, b, h) do { _Pragma("unroll") for (int m = 0; m < 4; ++m) _Pragma("unroll") for (int k = 0; k < 2; ++k) dst[m][k] = *(const PG8_LAS bf16x8*)(lds + PG8_SA(b, h) + aoff + m * 2048 + k * 1024); } while (0)
#define PG8_LDB(dst, b, h) do { _Pragma("unroll") for (int n = 0; n < 2; ++n) _Pragma("unroll") for (int k = 0; k < 2; ++k) dst[n][k] = *(const PG8_LAS bf16x8*)(lds + PG8_SB(b, h) + boff + n * 2048 + k * 1024); } while (0)
#define PG8_MMA(ai, bj, At, Bt) do { __builtin_amdgcn_s_setprio(1); _Pragma("unroll") for (int m = 0; m < 4; ++m) _Pragma("unroll") for (int n = 0; n < 2; ++n) _Pragma("unroll") for (int k = 0; k < 2; ++k) \
        acc[ai][bj][m][n] = __builtin_amdgcn_mfma_f32_16x16x32_bf16(Bt[n][k], At[m][k], acc[ai][bj][m][n], 0, 0, 0); __builtin_amdgcn_s_setprio(0); } while (0)
#define PG8_WAIT_V(n) asm volatile("s_waitcnt vmcnt(" #n ")" ::: "memory")
#define PG8_WAIT_L(n) asm volatile("s_waitcnt lgkmcnt(" #n ")" ::: "memory")
#define PG8_BAR __builtin_amdgcn_s_barrier()
#define PG8_SCHED __builtin_amdgcn_sched_barrier(0)
    Unit cur, nxt; int ui = 0;
    if (!S.next(0, cur)) return;
    f32x4 acc[2][2][4][2];
#pragma unroll
    for (int a = 0; a < 2; ++a)
#pragma unroll
        for (int b = 0; b < 2; ++b)
#pragma unroll
            for (int m = 0; m < 4; ++m)
#pragma unroll
                for (int n = 0; n < 2; ++n) acc[a][b][m][n] = (f32x4){0.f, 0.f, 0.f, 0.f};
    bf16x8 At[4][2], B0[2][2], B1[2][2];
    const char* cA = (const char*)g.A + (size_t)cur.pm * tstep; const char* cB = (const char*)g.Bt + (size_t)cur.pn * tstep;
    S.a_ready(cur);
    if constexpr (SP2) {
        PG8_STAGE(PG8_SB(0, 0), cB, voffB); PG8_STAGE(PG8_SB(0, 1), cB + hstep, voffB); PG8_STAGE(PG8_SA(0, 0), cA, voffA); PG8_STAGE(PG8_SA(0, 1), cA + hstep, voffA);
        if (wr == 1) PG8_BAR;
        PG8_WAIT_V(2); PG8_BAR;
        PG8_STAGE(PG8_SB(1, 0), cB + kstep, voffB); PG8_STAGE(PG8_SA(1, 0), cA + kstep, voffA); PG8_STAGE(PG8_SB(1, 1), cB + hstep + kstep, voffB);
        PG8_WAIT_V(6); PG8_BAR;
    } else {
        PG8_STAGE(PG8_SB(0, 0), cB, voffB); PG8_STAGE(PG8_SA(0, 0), cA, voffA); PG8_STAGE(PG8_SB(0, 1), cB + hstep, voffB); PG8_STAGE(PG8_SA(0, 1), cA + hstep, voffA);
        if (wr == 1) PG8_BAR;
        PG8_WAIT_V(4); PG8_BAR;
        PG8_STAGE(PG8_SB(1, 0), cB + kstep, voffB); PG8_STAGE(PG8_SA(1, 0), cA + kstep, voffA); PG8_STAGE(PG8_SB(1, 1), cB + hstep + kstep, voffB);
        PG8_WAIT_V(6); PG8_BAR;
    }
    for (;;) {
        const bool has_next = S.next(ui + 1, nxt);
        const char* nA = has_next ? (const char*)g.A + (size_t)nxt.pm * tstep : cA; const char* nB = has_next ? (const char*)g.Bt + (size_t)nxt.pn * tstep : cB;
        for (int t = 0; t < nt; t += 2) {
            const bool last = (t == nt - 2);
            const char* a1 = cA + (size_t)(t + 1) * kstep;
            const char* a2 = last ? nA : cA + (size_t)(t + 2) * kstep; const char* b2 = last ? nB : cB + (size_t)(t + 2) * kstep;
            const char* a3 = a2 + kstep; const char* b3 = b2 + kstep;
            if (last && has_next) S.a_ready(nxt);
            if constexpr (SP2) {
            PG8_LDB(B0, 0, 0); PG8_LDB(B1, 0, 1); PG8_SCHED; PG8_LDA(At, 0, 0); PG8_STAGE(PG8_SA(1, 1), a1 + hstep, voffA);
            PG8_WAIT_V(8); PG8_WAIT_L(0); PG8_BAR; PG8_MMA(0, 0, At, B0); PG8_MMA(0, 1, At, B1); PG8_BAR; PG8_SCHED;
            PG8_LDA(At, 0, 1); PG8_STAGE(PG8_SB(0, 0), b2, voffB); PG8_STAGE(PG8_SB(0, 1), b2 + hstep, voffB); PG8_STAGE(PG8_SA(0, 0), a2, voffA);
            PG8_WAIT_V(8); PG8_WAIT_L(0); PG8_BAR; PG8_MMA(1, 0, At, B0); PG8_MMA(1, 1, At, B1); PG8_BAR; PG8_SCHED;
            PG8_LDB(B0, 1, 0); PG8_LDB(B1, 1, 1); PG8_SCHED; PG8_LDA(At, 1, 0); PG8_STAGE(PG8_SA(0, 1), a2 + hstep, voffA);
            PG8_WAIT_V(8); PG8_WAIT_L(0); PG8_BAR; PG8_MMA(0, 0, At, B0); PG8_MMA(0, 1, At, B1); PG8_BAR; PG8_SCHED;
            PG8_LDA(At, 1, 1); PG8_STAGE(PG8_SB(1, 0), b3, voffB); PG8_STAGE(PG8_SB(1, 1), b3 + hstep, voffB); PG8_STAGE(PG8_SA(1, 0), a3, voffA);
            PG8_WAIT_V(8); PG8_WAIT_L(0); PG8_BAR; PG8_MMA(1, 0, At, B0); PG8_MMA(1, 1, At, B1); PG8_BAR; PG8_SCHED;
            } else {
            PG8_LDB(B0, 0, 0); PG8_SCHED; PG8_LDA(At, 0, 0); PG8_STAGE(PG8_SA(1, 1), a1 + hstep, voffA);
            PG8_WAIT_L(8); PG8_BAR; PG8_WAIT_L(0); PG8_MMA(0, 0, At, B0); PG8_BAR; PG8_SCHED;
            PG8_LDB(B1, 0, 1); PG8_STAGE(PG8_SB(0, 0), b2, voffB);
            PG8_BAR; PG8_WAIT_L(0); PG8_MMA(0, 1, At, B1); PG8_BAR;
            PG8_LDA(At, 0, 1); PG8_STAGE(PG8_SA(0, 0), a2, voffA);
            PG8_BAR; PG8_WAIT_L(0); PG8_MMA(1, 0, At, B0); PG8_BAR; PG8_SCHED;
            PG8_STAGE(PG8_SB(0, 1), b2 + hstep, voffB);
            PG8_WAIT_V(6); PG8_BAR; PG8_MMA(1, 1, At, B1); PG8_BAR;
            PG8_LDB(B0, 1, 0); PG8_SCHED; PG8_LDA(At, 1, 0); PG8_STAGE(PG8_SA(0, 1), a2 + hstep, voffA);
            PG8_WAIT_L(8); PG8_BAR; PG8_WAIT_L(0); PG8_MMA(0, 0, At, B0); PG8_BAR; PG8_SCHED;
            PG8_LDB(B1, 1, 1); PG8_STAGE(PG8_SB(1, 0), b3, voffB);
            PG8_BAR; PG8_WAIT_L(0); PG8_MMA(0, 1, At, B1); PG8_BAR;
            PG8_LDA(At, 1, 1); PG8_STAGE(PG8_SA(1, 0), a3, voffA);
            PG8_BAR; PG8_WAIT_L(0); PG8_MMA(1, 0, At, B0); PG8_BAR; PG8_SCHED;
            PG8_STAGE(PG8_SB(1, 1), b3 + hstep, voffB);
            PG8_WAIT_V(6); PG8_BAR; PG8_MMA(1, 1, At, B1); PG8_BAR;
            }
        }
        if constexpr (ALIGN_EPI) { if (wr == 0) PG8_BAR; }
        if constexpr (!Epi::AFTER_DRAIN) { E(acc, cur, wr, wc, fr, fq); S.done(cur); }
        if (!has_next) break;
#pragma unroll
        for (int a = 0; a < 2; ++a)
#pragma unroll
            for (int b = 0; b < 2; ++b)
#pragma unroll
                for (int m = 0; m < 4; ++m)
#pragma unroll
                    for (int n = 0; n < 2; ++n) acc[a][b][m][n] = (f32x4){0.f, 0.f, 0.f, 0.f};
        cur = nxt; cA = nA; cB = nB; ++ui;
        if constexpr (ALIGN_EPI) { if (wr == 1) PG8_BAR; }
    }
    PG8_WAIT_V(0);
    if constexpr (!ALIGN_EPI) { if (wr == 0) PG8_BAR; }
    PG8_BAR;
    if constexpr (Epi::AFTER_DRAIN) { E.fused(acc, cur, wr, wc, fr, fq, lds, wid, lane); S.done(cur); }
#undef PG8_SA
#undef PG8_SB
#undef PG8_STAGE
#undef PG8_LDA
#undef PG8_LDB
#undef PG8_MMA
#undef PG8_WAIT_V
#undef PG8_WAIT_L
#undef PG8_BAR
#undef PG8_SCHED
}
}

constexpr int DM = 2048, FF = 5632, NPROMPT = 8192, NSAMP = 128, NTOK = 8320, MP = 8448, SEQ = 2048, NBATCH = 4;
constexpr int NGU = 2 * FF;
constexpr int LDP = 14848;
constexpr int NPROJ = 15104;
constexpr int PQ = 0, PK = 1024, PV = 2048, POG = 4096, PZ = 6144, PXBC = 8192, PGATE = 10752;
constexpr int XBC = 2560, IN_DIM = 14888;
constexpr float NEG_INIT = -1e30f;
constexpr size_t O_Y = 0, O_PCONV = 17039360, O_PC = 17070080, O_PN = 19167232, O_PM = 19171328, O_PSSM = 19171344,
                 O_SCONV = 20219920, O_SC = 21202960, O_SN = 88311824, O_SM = 88442896, O_SSSM = 88443408;
constexpr size_t MiB = 1u << 20;
constexpr size_t WS_SSQ = 0, WS_BAR = 1 * MiB, WS_WGU1 = 2 * MiB, WS_WD1 = 46 * MiB, WS_WIN = 68 * MiB, WS_WOUT = 127 * MiB, WS_WGU2 = 135 * MiB, WS_WD2 = 179 * MiB,
                 WS_XB = 202 * MiB, WS_MERGED = 235 * MiB, WS_X1 = 268 * MiB, WS_H = 334 * MiB, WS_PROJ = 425 * MiB, WS_GSM = 665 * MiB, WS_HML = 668 * MiB, WS_YS = 734 * MiB, WS_XA = 800 * MiB, WS_END = 844 * MiB;
constexpr int SSQ0 = 0, SSQ1 = MP, SSQ2 = 2 * MP, SSQ3 = 3 * MP, SSQA = 4 * MP, SSQB = 8 * MP, SSQ_WORDS = 10 * MP;
constexpr int LDS_BYTES = 147456;
constexpr int NWAVES = 8, NTHR = 512;

#define LAS __attribute__((address_space(3)))
typedef unsigned short bf16;
typedef float f32x4 __attribute__((ext_vector_type(4)));
typedef short bf16x8 __attribute__((ext_vector_type(8)));
typedef unsigned u32x4 __attribute__((ext_vector_type(4)));
typedef unsigned u32x2 __attribute__((ext_vector_type(2)));
typedef unsigned long long u64;
typedef float f32x2 __attribute__((ext_vector_type(2)));
using pg8::pk_bf16; using pg8::SSQ_SCALE; using pg8::rs_from; using pg8::silu_f; using pg8::sigm_f;
DI float bf2f(unsigned v) { return __uint_as_float(v << 16); }
DI bf16 f2bf(float f) { return (bf16)(pk_bf16(f, 0.f) & 0xffffu); }
DI float wave_sum(float v) {
#pragma unroll
    for (int o = 1; o < 64; o <<= 1) v += __shfl_xor(v, o);
    return v;
}
typedef short s16x4 __attribute__((ext_vector_type(4)));
DI s16x4 lds_tr4(const LAS unsigned short* p) { return __builtin_amdgcn_ds_read_tr16_b64_v4i16((LAS s16x4*)p); }
DI f32x4 mfma16(bf16x8 a, bf16x8 b, f32x4 c) { return __builtin_amdgcn_mfma_f32_16x16x32_bf16(a, b, c, 0, 0, 0); }
DI float log_sigmoid(float x) { return fminf(x, 0.f) - log1pf(__expf(-fabsf(x))); }
DI float softplus_f(float x) { return fmaxf(x, 0.f) + log1pf(__expf(-fabsf(x))); }

struct Args { const float* in[28]; float* out; unsigned char* ws; };

DI int map_in(int n) {
    if (n < 4096) return n;
    if (n < 4100) return 14848 + (n - 4096);
    if (n < 4104) return 14852 + (n - 4100);
    if (n < 6152) return POG + (n - 4104);
    if (n < 8200) return PZ + (n - 6152);
    if (n < 10760) return PXBC + (n - 8200);
    if (n < 10792) return 14856 + (n - 10760);
    return PGATE + (n - 10792);
}
struct TItem { const float* W; bf16* WT; const float* wk; int K, N, mode, k0, n0; };
DI TItem decode_item(const Args& a, int it) {
    constexpr int I_G = (DM / 64) * (FF / 64), I_D = (FF / 64) * (DM / 64), I_IN = (DM / 64) * ((IN_DIM + 63) / 64), I_O = (DM / 64) * (DM / 64);
    unsigned char* ws = a.ws; TItem d; int r = it, nblk;
    if (r < I_G) { d.W = a.in[8]; d.WT = (bf16*)(ws + WS_WGU1); d.wk = a.in[7]; d.K = DM; d.N = FF; d.mode = 1; }
    else if ((r -= I_G) < I_G) { d.W = a.in[9]; d.WT = (bf16*)(ws + WS_WGU1); d.wk = a.in[7]; d.K = DM; d.N = FF; d.mode = 2; }
    else if ((r -= I_G) < I_IN) { d.W = a.in[12]; d.WT = (bf16*)(ws + WS_WIN); d.wk = a.in[11]; d.K = DM; d.N = IN_DIM; d.mode = 3; }
    else if ((r -= I_IN) < I_D) { d.W = a.in[10]; d.WT = (bf16*)(ws + WS_WD1); d.wk = nullptr; d.K = FF; d.N = DM; d.mode = 0; }
    else if ((r -= I_D) < I_G) { d.W = a.in[24]; d.WT = (bf16*)(ws + WS_WGU2); d.wk = a.in[23]; d.K = DM; d.N = FF; d.mode = 1; }
    else if ((r -= I_G) < I_O) { d.W = a.in[22]; d.WT = (bf16*)(ws + WS_WOUT); d.wk = nullptr; d.K = DM; d.N = DM; d.mode = 0; }
    else if ((r -= I_O) < I_D) { d.W = a.in[26]; d.WT = (bf16*)(ws + WS_WD2); d.wk = nullptr; d.K = FF; d.N = DM; d.mode = 0; }
    else { r -= I_D; d.W = a.in[25]; d.WT = (bf16*)(ws + WS_WGU2); d.wk = a.in[23]; d.K = DM; d.N = FF; d.mode = 2; }
    nblk = (d.N + 63) / 64; d.k0 = 64 * (r / nblk); d.n0 = 64 * (r % nblk);
    return d;
}
DI void titem_load(const TItem& d, f32x4 (&v)[16], float (&kw)[16], int lane) {
    const int n = d.n0 + 4 * (lane & 15), kq = lane >> 4; const bool ok = n < d.N;
#pragma unroll
    for (int i = 0; i < 16; ++i) { v[i] = (f32x4){0.f, 0.f, 0.f, 0.f}; if (ok) v[i] = __builtin_nontemporal_load((const f32x4*)(d.W + (size_t)(d.k0 + 4 * i + kq) * d.N + n)); }
#pragma unroll
    for (int i = 0; i < 16; ++i) kw[i] = d.wk ? d.wk[d.k0 + 4 * i + kq] : 1.f;
}
DI void titem_store(const TItem& d, const f32x4 (&v)[16], const float (&kw)[16], LAS float* scr, int lane) {
    const int kq = lane >> 4, nl4 = 4 * (lane & 15);
#pragma unroll
    for (int i = 0; i < 16; ++i) { LAS float* p = scr + (4 * i + kq) * 65 + nl4; const f32x4 x = v[i] * kw[i]; p[0] = x[0]; p[1] = x[1]; p[2] = x[2]; p[3] = x[3]; }
    asm volatile("s_waitcnt lgkmcnt(0)" ::: "memory");
    const int c = lane & 7;
#pragma unroll
    for (int j = 0; j < 8; ++j) { const int nl = (lane >> 3) + 8 * j, n = d.n0 + nl; const LAS float* s = scr + (8 * c) * 65 + nl;
        if (n < d.N) {
            int dst; float sc = 1.f;
            if (d.mode == 0) dst = n; else if (d.mode == 1) dst = (n >> 7) * 256 + (n & 127); else if (d.mode == 2) dst = (n >> 7) * 256 + 128 + (n & 127); else { dst = map_in(n); if (n < 1024) sc = 0.0625f; }
            u32x4 o; o.x = pk_bf16(s[0 * 65] * sc, s[1 * 65] * sc); o.y = pk_bf16(s[2 * 65] * sc, s[3 * 65] * sc); o.z = pk_bf16(s[4 * 65] * sc, s[5 * 65] * sc); o.w = pk_bf16(s[6 * 65] * sc, s[7 * 65] * sc);
            *(u32x4*)(d.WT + (size_t)dst * d.K + d.k0 + 8 * c) = o; } }
    asm volatile("s_waitcnt lgkmcnt(0)" ::: "memory");
}
constexpr int CV_I_G = (DM / 64) * (FF / 64), CV_I_D = (FF / 64) * (DM / 64), CV_I_IN = (DM / 64) * ((IN_DIM + 63) / 64), CV_I_O = (DM / 64) * (DM / 64);
constexpr int CV_PROLOGUE_END = 2 * CV_I_G + CV_I_IN, CV_G1TAIL_END = CV_PROLOGUE_END + CV_I_D + CV_I_G, CV_END = CV_G1TAIL_END + CV_I_O + CV_I_D + CV_I_G;
DI void convert_items(LAS unsigned char* lds, const Args& a, int first, int last, int widx, int nworkers) {
    int tid_ = threadIdx.x; asm volatile("" : "+v"(tid_)); const int tid = tid_, lane = tid & 63, wave = __builtin_amdgcn_readfirstlane(tid >> 6);
    LAS float* scr = (LAS float*)(lds + wave * 16640);
    int it = first + widx;
    if (it < last) {
        TItem d = decode_item(a, it); f32x4 cur[16]; float ckw[16];
        titem_load(d, cur, ckw, lane);
        for (;;) {
            const int itn = it + nworkers; const bool more = itn < last;
            TItem dn = d; f32x4 nxt[16]; float nkw[16];
            if (more) { dn = decode_item(a, itn); titem_load(dn, nxt, nkw, lane); }
            titem_store(d, cur, ckw, scr, lane);
            if (!more) break;
#pragma unroll
            for (int i = 0; i < 16; ++i) { cur[i] = nxt[i]; ckw[i] = nkw[i]; }
            d = dn; it = itn;
        }
    }
}
DI void p0_prologue(LAS unsigned char* lds, const Args& a, int vcu, int G) {
    int tid_ = threadIdx.x; asm volatile("" : "+v"(tid_)); const int tid = tid_, lane = tid & 63, wave = __builtin_amdgcn_readfirstlane(tid >> 6);
    unsigned char* ws = a.ws;
    LAS float* scr = (LAS float*)(lds + wave * 16640);
    const int gw = vcu * NWAVES + wave, NGW = G * NWAVES;
    { u64* q = (u64*)(ws + WS_SSQ); for (int i = (int)(blockIdx.x * NTHR + tid); i < SSQ_WORDS - MP; i += G * NTHR) q[MP + i] = 0ull; }
    constexpr int I_G = (DM / 64) * (FF / 64), I_D = (FF / 64) * (DM / 64), I_IN = (DM / 64) * ((IN_DIM + 63) / 64), I_O = (DM / 64) * (DM / 64);
    constexpr int NITEMS = 4 * I_G + 2 * I_D + I_IN + I_O;
    bf16* xb = (bf16*)(ws + WS_XB); u64* ssq0 = (u64*)(ws + WS_SSQ) + SSQ0;
    for (int m = gw; m < NTOK; m += NGW) {
        const float* xr = m < NPROMPT ? a.in[0] + (size_t)m * DM : a.in[1] + (size_t)(m - NPROMPT) * DM;
        f32x4 v[8];
#pragma unroll
        for (int j = 0; j < 8; ++j) v[j] = *(const f32x4*)(xr + 4 * lane + 256 * j);
        float ss = 0.f;
#pragma unroll
        for (int j = 0; j < 8; ++j) { ss += (v[j][0] * v[j][0] + v[j][1] * v[j][1]) + (v[j][2] * v[j][2] + v[j][3] * v[j][3]);
            u32x2 w; w.x = pk_bf16(v[j][0], v[j][1]); w.y = pk_bf16(v[j][2], v[j][3]); *(u32x2*)(xb + (size_t)m * DM + 4 * lane + 256 * j) = w; }
        ss = wave_sum(ss);
        if (lane == 0) ssq0[m] = (u64)(ss * SSQ_SCALE);
    }
    convert_items(lds, a, 0, CV_PROLOGUE_END, gw, NGW);
}

DI void conv_pass(const Args& a, int vcu, int G) {
    int tid_ = threadIdx.x; asm volatile("" : "+v"(tid_)); const int tid = tid_;
    const bf16* proj = (const bf16*)(a.ws + WS_PROJ); bf16* XA = (bf16*)(a.ws + WS_XA);
    const float* cwt = a.in[16]; const float* cbs = a.in[17]; const float* stc = a.in[2];
    const int gt = vcu * NTHR + tid, NGT = G * NTHR;
    constexpr int NCG = XBC / 8, RUN = 16, NRUN = NPROMPT / RUN;
    for (int item = gt; item < NRUN * NCG + NSAMP * NCG; item += NGT) {
        const bool samp = item >= NRUN * NCG; const int it2 = samp ? item - NRUN * NCG : item;
        const int cg8 = it2 % NCG, run = it2 / NCG, ch = 8 * cg8;
        float wv[4][8], bs[8];
#pragma unroll
        for (int jj = 0; jj < 4; ++jj) { const f32x4 w0 = *(const f32x4*)(cwt + jj * XBC + ch), w1 = *(const f32x4*)(cwt + jj * XBC + ch + 4);
#pragma unroll
            for (int e = 0; e < 4; ++e) { wv[jj][e] = w0[e]; wv[jj][4 + e] = w1[e]; } }
        { const f32x4 b0 = *(const f32x4*)(cbs + ch), b1 = *(const f32x4*)(cbs + ch + 4);
#pragma unroll
          for (int e = 0; e < 4; ++e) { bs[e] = b0[e]; bs[4 + e] = b1[e]; } }
        if (!samp) {
            const int b = run / (SEQ / RUN), t0 = (run % (SEQ / RUN)) * RUN;
            const bf16* base = proj + ((size_t)b * SEQ) * LDP + PXBC + ch;
            u32x4 rw[RUN + 3];
#pragma unroll
            for (int r = 0; r < RUN + 3; ++r) { const int tt = t0 - 3 + r; rw[r] = (u32x4){0u, 0u, 0u, 0u}; if (tt >= 0) rw[r] = *(const u32x4*)(base + (size_t)tt * LDP); }
#pragma unroll
            for (int r = 0; r < RUN; ++r) { float o[8];
#pragma unroll
                for (int e = 0; e < 8; ++e) { float acc = bs[e];
#pragma unroll
                    for (int jj = 0; jj < 4; ++jj) { const unsigned word = rw[r + jj][e >> 1]; acc += wv[jj][e] * ((e & 1) ? __uint_as_float(word & 0xffff0000u) : __uint_as_float(word << 16)); }
                    o[e] = silu_f(acc); }
                u32x4 ov; ov.x = pk_bf16(o[0], o[1]); ov.y = pk_bf16(o[2], o[3]); ov.z = pk_bf16(o[4], o[5]); ov.w = pk_bf16(o[6], o[7]);
                *(u32x4*)(XA + ((size_t)b * SEQ + t0 + r) * XBC + ch) = ov; }
        } else {
            const int bs_i = run; const float* st = stc + (size_t)bs_i * 3 * XBC + ch; const u32x4 nw = *(const u32x4*)(proj + ((size_t)NPROMPT + bs_i) * LDP + PXBC + ch);
            float o[8];
#pragma unroll
            for (int e = 0; e < 8; ++e) { const unsigned word = nw[e >> 1]; const float xv = (e & 1) ? __uint_as_float(word & 0xffff0000u) : __uint_as_float(word << 16);
                o[e] = silu_f(bs[e] + wv[0][e] * st[e] + wv[1][e] * st[XBC + e] + wv[2][e] * st[2 * XBC + e] + wv[3][e] * xv); }
            u32x4 ov; ov.x = pk_bf16(o[0], o[1]); ov.y = pk_bf16(o[2], o[3]); ov.z = pk_bf16(o[4], o[5]); ov.w = pk_bf16(o[6], o[7]);
            *(u32x4*)(XA + ((size_t)NPROMPT + bs_i) * XBC + ch) = ov;
        }
    }
}

constexpr int ML_CT = 0, ML_KS = 34320, ML_VT = 101904, ML_VTW = 119584, ML_SB = 137264, ML_SBN = 516;
DI float mlstm_scan(float ig0, float ig1, float fg0, float fg1, float ib, float fb, int lane, LAS float* sb, float mst) {
    const float li0 = ig0 + ib, li1 = ig1 + ib, lf0 = log_sigmoid(fg0 + fb), lf1 = log_sigmoid(fg1 + fb);
    float s = lf0 + lf1;
#pragma unroll
    for (int o = 1; o < 64; o <<= 1) { const float tv = __shfl_up(s, o); if (lane >= o) s += tv; }
    const float b1 = s, b0 = s - lf1, g0 = li0 - b0, g1 = li1 - b1;
    float pmx = fmaxf(g0, g1);
#pragma unroll
    for (int o = 1; o < 64; o <<= 1) { const float tv = __shfl_up(pmx, o); if (lane >= o) pmx = fmaxf(pmx, tv); }
    float prev = __shfl_up(pmx, 1); if (lane == 0) prev = -INFINITY;
    const float M0 = fmaxf(mst, fmaxf(prev, g0)), M1 = fmaxf(mst, pmx);
    const float M127 = __shfl(M1, 63), b127 = __shfl(b1, 63);
    *(LAS f32x2*)(sb + 2 * lane) = (f32x2){g0, g1}; *(LAS f32x2*)(sb + 128 + 2 * lane) = (f32x2){b0, b1}; *(LAS f32x2*)(sb + 256 + 2 * lane) = (f32x2){M0, M1};
    *(LAS f32x2*)(sb + 384 + 2 * lane) = (f32x2){__expf(g0 - M127), __expf(g1 - M127)};
    if (lane == 0) { sb[512] = __expf(mst - M127); sb[513] = b127 + M127; sb[514] = mst; }
    return b127 + M127;
}
DI void mlstm_prompt_unit(LAS unsigned char* lds, int unit, const bf16* proj, const float* gsm, const float* i_bias, const float* f_bias,
                          bf16* hml, u64* ssqA, float* pC, float* pn, float* pm, bool atom) {
    int tid_ = threadIdx.x; asm volatile("" : "+v"(tid_)); const int tid = tid_, lane = tid & 63, w = __builtin_amdgcn_readfirstlane(tid >> 6), fr = lane & 15, fq = lane >> 4;
    const int bh = unit >> 3, j = unit & 7, b = bh >> 2, h = bh & 3;
    LAS bf16* CT = (LAS bf16*)(lds + ML_CT); LAS bf16* Ks = (LAS bf16*)(lds + ML_KS); LAS bf16* Vt = (LAS bf16*)(lds + ML_VT); LAS bf16* Vtw = (LAS bf16*)(lds + ML_VTW);
    LAS float* sbuf = (LAS float*)(lds + ML_SB);
    for (int i = tid; i < 65 * 264 / 2; i += NTHR) ((LAS unsigned*)CT)[i] = 0u;
    if (tid < 136) Vt[64 * 136 + tid] = (bf16)0x3F80u;
    f32x4 Cacc[2][5];
#pragma unroll
    for (int e = 0; e < 2; ++e)
#pragma unroll
        for (int d = 0; d < 5; ++d) Cacc[e][d] = (f32x4){0.f, 0.f, 0.f, 0.f};
    const float ib = i_bias[h], fb = f_bias[h];
    const size_t tokb = (size_t)b * SEQ;
    u32x4 kreg[8], vreg[2]; bf16x8 qnx[8]; float mrun = NEG_INIT;
    const unsigned koff = (unsigned)((tid >> 5) * (LDP * 2) + (tid & 31) * 16), voff = (unsigned)((tid >> 2) * (LDP * 2) + (tid & 3) * 32);
    const unsigned qoff = (unsigned)((16 * w + fr) * (LDP * 2) + fq * 16), goff = (unsigned)lane * 512u, hoff = (unsigned)((16 * w + fr) * (DM * 2) + fq * 8);
    const char* pk0 = (const char*)(proj + tokb * LDP + PK + h * 256); const char* pv0 = (const char*)(proj + tokb * LDP + PV + h * 512 + 64 * j);
    const char* pq0 = (const char*)(proj + tokb * LDP + PQ + h * 256); const char* pg0 = (const char*)(gsm + tokb * 64 + h); char* ph0 = (char*)(hml + tokb * DM + h * 512 + 64 * j);
#define ML_LOAD_KV(c_) do { const size_t cb_ = (size_t)(c_) * 128 * LDP * 2; \
        _Pragma("unroll") for (int i = 0; i < 8; ++i) kreg[i] = *(const u32x4*)(pk0 + cb_ + (size_t)i * 16 * LDP * 2 + koff); \
        _Pragma("unroll") for (int i = 0; i < 2; ++i) vreg[i] = *(const u32x4*)(pv0 + cb_ + 16 * i + voff); \
        _Pragma("unroll") for (int kk = 0; kk < 8; ++kk) qnx[kk] = *(const bf16x8*)(pq0 + cb_ + 64 * kk + qoff); \
        } while (0)
#define ML_LOAD_G(c_) do { { const char* gp_ = pg0 + (size_t)(c_) * 128 * 256 + goff; gz[0] = *(const float*)gp_; gz[1] = *(const float*)(gp_ + 256); gz[2] = *(const float*)(gp_ + 16); gz[3] = *(const float*)(gp_ + 256 + 16); } } while (0)
    ML_LOAD_KV(0);
    if (w == 0) { float gz[4]; ML_LOAD_G(0); mrun = mlstm_scan(gz[0], gz[1], gz[2], gz[3], ib, fb, lane, sbuf, mrun); }
    __syncthreads();
#define LAUNDER(p) asm volatile("" : "+v"(p))
    for (int c = 0; c < 16; ++c) {
        const size_t tok0 = tokb + (size_t)c * 128;
        LAS float* sc = sbuf + (c & 1) * ML_SBN; LAS float* sn = sbuf + ((c + 1) & 1) * ML_SBN;
        const int t = 16 * w + fr;
        LAS bf16* ksw = Ks + (tid >> 5) * 264 + 8 * (tid & 31); LAS bf16* vtw_ = Vt + (16 * (tid & 3)) * 136 + (tid >> 2);
        const LAS bf16* ksr = Ks + fr * 264 + 8 * fq; const LAS bf16* ctr = CT + fr * 264 + 8 * fq; const LAS bf16* vtr = Vt + fr * 136 + 4 * fq; const LAS bf16* vtwr = Vtw + fr * 136 + 8 * fq;
        const LAS bf16* kgr = Ks + (8 * fq + (fr >> 2)) * 264 + 32 * w + 4 * (fr & 3); LAS bf16* ctw = CT + (4 * fq) * 264 + 32 * w + fr;
        const LAS float* scq = sc + 4 * fq; const LAS float* sct = sc + t; const LAS float* scs = sc + (tid >> 2);
        LAUNDER(ksw); LAUNDER(vtw_); LAS bf16* vtww = vtw_ + (ML_VTW - ML_VT) / 2; LAUNDER(ksr); LAUNDER(ctr); LAUNDER(vtr); LAUNDER(vtwr); LAUNDER(kgr); LAUNDER(ctw); LAUNDER(scq); LAUNDER(sct); LAUNDER(scs);
        bf16x8 qf[8];
#pragma unroll
        for (int kk = 0; kk < 8; ++kk) qf[kk] = qnx[kk];
#pragma unroll
        for (int i = 0; i < 8; ++i) *(LAS u32x4*)(ksw + i * 16 * 264) = kreg[i];
        {   const float we = scs[384];
#pragma unroll
            for (int e = 0; e < 16; ++e) { const unsigned word = vreg[e >> 3][(e >> 1) & 3]; const unsigned raw = (e & 1) ? (word >> 16) : (word & 0xffffu);
                vtw_[e * 136] = (bf16)raw; vtww[e * 136] = f2bf(bf2f(raw) * we); }
            if (tid < 128) Vtw[64 * 136 + tid] = f2bf(sc[384 + tid]); }
        __syncthreads();
        {
            const float Mt = sct[256], mold = sc[514];
            bf16x8 af[4];
#pragma unroll
            for (int p = 0; p < 4; ++p) { u32x4 pw;
#pragma unroll
                for (int hf = 0; hf < 2; ++hf) { const int sb = 2 * p + hf; f32x4 sa = (f32x4){0.f, 0.f, 0.f, 0.f};
                    if (sb <= w) {
#pragma unroll
                        for (int kk = 0; kk < 8; ++kk) { const bf16x8 kf = *(const LAS bf16x8*)(ksr + (16 * sb) * 264 + 32 * kk); sa = mfma16(kf, qf[kk], sa); } }
                    float v[4]; const f32x4 g4v = *(const LAS f32x4*)(scq + 16 * sb);
#pragma unroll
                    for (int i = 0; i < 4; ++i) { const int s = 16 * sb + 4 * fq + i; v[i] = (sb <= w && s <= t) ? sa[i] * __expf(g4v[i] - Mt) : 0.f; }
                    pw[2 * hf] = pk_bf16(v[0], v[1]); pw[2 * hf + 1] = pk_bf16(v[2], v[3]); }
                af[p] = __builtin_bit_cast(bf16x8, pw);
                __builtin_amdgcn_sched_barrier(0); }
#define ML_NACC(db, dst) do { dst = (f32x4){0.f, 0.f, 0.f, 0.f}; _Pragma("unroll") for (int p = 0; p < 4; ++p) if (2 * p <= w) { const LAS bf16* vp = vtr + (16 * (db)) * 136 + 32 * p; \
                const u32x2 lo = *(const LAS u32x2*)vp, hi = *(const LAS u32x2*)(vp + 16); u32x4 vv; vv.x = lo.x; vv.y = lo.y; vv.z = hi.x; vv.w = hi.y; dst = mfma16(__builtin_bit_cast(bf16x8, vv), af[p], dst); } } while (0)
#define ML_CACC(db, dst) do { dst = (f32x4){0.f, 0.f, 0.f, 0.f}; _Pragma("unroll") for (int kk = 0; kk < 8; ++kk) { const bf16x8 cf = *(const LAS bf16x8*)(ctr + (16 * (db)) * 264 + 32 * kk); dst = mfma16(cf, qf[kk], dst); } } while (0)
            f32x4 n4, c4; ML_NACC(4, n4); ML_CACC(4, c4);
            const float rowsum = __shfl(n4[0], fr), qn = __shfl(c4[0], fr);
            const float winter = __expf(mold - Mt), den = rowsum + winter * qn, mt = sct[128] + Mt;
            const float inv = 1.0f / fmaxf(fabsf(den), __expf(-mt));
            float ss = 0.f;
#pragma unroll
            for (int db = 0; db < 4; ++db) { f32x4 na, ca; ML_NACC(db, na); ML_CACC(db, ca);
                const f32x4 hv = (na + ca * winter) * inv; ss += (hv[0] * hv[0] + hv[1] * hv[1]) + (hv[2] * hv[2] + hv[3] * hv[3]);
                { u32x2 hw_; hw_.x = pk_bf16(hv[0], hv[1]); hw_.y = pk_bf16(hv[2], hv[3]); *(u32x2*)(ph0 + (size_t)c * 128 * DM * 2 + 32 * db + hoff) = hw_; } }
#undef ML_NACC
#undef ML_CACC
            ss += __shfl_xor(ss, 16); ss += __shfl_xor(ss, 32);
            if (fq == 0 && atom) atomicAdd(ssqA + (tok0 + t) * 4 + h, (u64)(ss * SSQ_SCALE));
        }
        if (w == 0 && c < 15) { float gz[4]; ML_LOAD_G(c + 1); mrun = mlstm_scan(gz[0], gz[1], gz[2], gz[3], ib, fb, lane, sn, mrun); }
        __syncthreads();
        {
            if (c < 15) ML_LOAD_KV(c + 1);
            const float decay = sc[512];
#pragma unroll
            for (int e = 0; e < 2; ++e)
#pragma unroll
                for (int d = 0; d < 5; ++d) Cacc[e][d] = Cacc[e][d] * decay;
#pragma unroll
            for (int p = 0; p < 4; ++p) { bf16x8 vtw[5];
#pragma unroll
                for (int db = 0; db < 5; ++db) vtw[db] = *(const LAS bf16x8*)(vtwr + (16 * db) * 136 + 32 * p);
#pragma unroll
                for (int eb = 0; eb < 2; ++eb) { const s16x4 k0 = lds_tr4(kgr + (32 * p) * 264 + 16 * eb), k1 = lds_tr4(kgr + (32 * p + 4) * 264 + 16 * eb);
                    const bf16x8 kt = (bf16x8){k0[0], k0[1], k0[2], k0[3], k1[0], k1[1], k1[2], k1[3]};
#pragma unroll
                    for (int db = 0; db < 5; ++db) Cacc[eb][db] = mfma16(vtw[db], kt, Cacc[eb][db]); } }
#pragma unroll
            for (int eb = 0; eb < 2; ++eb) {
#pragma unroll
                for (int db = 0; db < 4; ++db)
#pragma unroll
                    for (int i = 0; i < 4; ++i) ctw[(16 * db + i) * 264 + 16 * eb] = f2bf(Cacc[eb][db][i]);
                if (fq == 0) ctw[64 * 264 + 16 * eb] = f2bf(Cacc[eb][4][0]); }
        }
        __syncthreads();
    }
#undef ML_LOAD_KV
#undef ML_LOAD_G
#pragma unroll
    for (int eb = 0; eb < 2; ++eb) {
#pragma unroll
        for (int db = 0; db < 4; ++db) *(f32x4*)(pC + ((size_t)bh * 256 + 32 * w + 16 * eb + fr) * 512 + 64 * j + 16 * db + 4 * fq) = Cacc[eb][db];
        if (j == 0 && fq == 0) pn[bh * 256 + 32 * w + 16 * eb + fr] = Cacc[eb][4][0]; }
    if (j == 0 && tid == 0) pm[bh] = sbuf[ML_SBN + 513];
    __syncthreads();
}

constexpr int SD_BS = 0, SD_CS = 34816, SD_XT = 69632, SD_XTW = 87040, SD_SB = 104448, SD_SC = 121856, SD_SCN = 388;
DI void ssd_scan(float r0, float r1, float dtb, float Aneg, int lane, LAS float* sb) {
    const float dt0 = softplus_f(r0 + dtb), dt1 = softplus_f(r1 + dtb), a0 = dt0 * Aneg, a1 = dt1 * Aneg;
    float s = a0 + a1;
#pragma unroll
    for (int o = 1; o < 64; o <<= 1) { const float tv = __shfl_up(s, o); if (lane >= o) s += tv; }
    const float b1 = s, b0 = s - a1, bl = __shfl(b1, 63);
    *(LAS f32x2*)(sb + 2 * lane) = (f32x2){b0, b1}; *(LAS f32x2*)(sb + 128 + 2 * lane) = (f32x2){dt0, dt1};
    *(LAS f32x2*)(sb + 256 + 2 * lane) = (f32x2){__expf(bl - b0) * dt0, __expf(bl - b1) * dt1};
    if (lane == 0) sb[384] = __expf(bl);
}
DI void ssd_prompt_unit(LAS unsigned char* lds, int unit, const bf16* proj, const bf16* XA, const float* gsm, const float* dt_bias, const float* A_log, const float* Dsk,
                        bf16* ys, u64* ssqB, float* pS, bool atom) {
    int tid_ = threadIdx.x; asm volatile("" : "+v"(tid_)); const int tid = tid_, lane = tid & 63, w = __builtin_amdgcn_readfirstlane(tid >> 6), fr = lane & 15, fq = lane >> 4;
    const int b = unit >> 5, head = unit & 31, g = head >> 4;
    LAS bf16* Bs = (LAS bf16*)(lds + SD_BS); LAS bf16* Cs = (LAS bf16*)(lds + SD_CS); LAS bf16* Xt = (LAS bf16*)(lds + SD_XT); LAS bf16* Xtw = (LAS bf16*)(lds + SD_XTW); LAS bf16* Sb = (LAS bf16*)(lds + SD_SB);
    LAS float* sbuf = (LAS float*)(lds + SD_SC);
    for (int i = tid; i < 64 * 136 / 2; i += NTHR) ((LAS unsigned*)Sb)[i] = 0u;
    f32x4 Sacc[4];
#pragma unroll
    for (int pb = 0; pb < 4; ++pb) Sacc[pb] = (f32x4){0.f, 0.f, 0.f, 0.f};
    const float dtb = dt_bias[head], Aneg = -__expf(A_log[head]), Dk = Dsk[head];
    const size_t tokb = (size_t)b * SEQ;
    u32x4 breg[4], creg[4], xreg[2];
    const unsigned boff = (unsigned)((tid >> 4) * (XBC * 2) + (tid & 15) * 16), xoff = (unsigned)((tid >> 3) * (XBC * 2) + (tid & 7) * 16);
    const unsigned zoff = (unsigned)((16 * w + fr) * (LDP * 2) + fq * 8), goff = (unsigned)lane * 512u, yoff = (unsigned)((16 * w + fr) * (DM * 2) + fq * 8);
    const char* pb0 = (const char*)(XA + tokb * XBC + 2048 + g * 128); const char* px0 = (const char*)(XA + tokb * XBC + head * 64);
    const char* pz0 = (const char*)(proj + tokb * LDP + PZ + head * 64); const char* pg0 = (const char*)(gsm + tokb * 64 + 8 + head); char* py0 = (char*)(ys + tokb * DM + head * 64);
#define SD_LOAD(c_) do { const size_t cb_ = (size_t)(c_) * 128 * XBC * 2; \
        _Pragma("unroll") for (int i = 0; i < 4; ++i) { const char* rp_ = pb0 + cb_ + (size_t)i * 32 * XBC * 2 + boff; breg[i] = *(const u32x4*)rp_; creg[i] = *(const u32x4*)(rp_ + 512); } \
        _Pragma("unroll") for (int i = 0; i < 2; ++i) xreg[i] = *(const u32x4*)(px0 + cb_ + (size_t)i * 64 * XBC * 2 + xoff); \
        } while (0)
#define SD_LOAD_G(c_) do { const char* gp_ = pg0 + (size_t)(c_) * 128 * 256 + goff; gz[0] = *(const float*)gp_; gz[1] = *(const float*)(gp_ + 256); } while (0)
    SD_LOAD(0);
    if (w == 0) { float gz[2]; SD_LOAD_G(0); ssd_scan(gz[0], gz[1], dtb, Aneg, lane, sbuf); }
    __syncthreads();
    for (int c = 0; c < 16; ++c) {
        const size_t tok0 = tokb + (size_t)c * 128;
        LAS float* sc = sbuf + (c & 1) * SD_SCN; LAS float* sn = sbuf + ((c + 1) & 1) * SD_SCN;
        const int t = 16 * w + fr;
        LAS bf16* bsw = Bs + (tid >> 4) * 136 + 8 * (tid & 15); LAS bf16* xtw_ = Xt + (8 * (tid & 7)) * 136 + (tid >> 3);
        const LAS bf16* csr = Cs + t * 136 + 8 * fq; const LAS bf16* bsr = Bs + fr * 136 + 8 * fq; const LAS bf16* xtr = Xt + fr * 136 + 4 * fq; const LAS bf16* sbr = Sb + fr * 136 + 8 * fq;
        const LAS bf16* xtx = Xt + (4 * fq) * 136 + t; const LAS bf16* bgr = Bs + (8 * fq + (fr >> 2)) * 136 + 16 * w + 4 * (fr & 3); const LAS bf16* xtwr = Xtw + fr * 136 + 8 * fq; LAS bf16* sbw = Sb + fr * 136 + 16 * w + 4 * fq;
        const LAS float* scq = sc + 4 * fq; const LAS float* sct = sc + t; const LAS float* scs = sc + (tid >> 3);
        LAUNDER(bsw); LAUNDER(xtw_); LAUNDER(csr); LAUNDER(bsr); LAUNDER(xtr); LAUNDER(sbr); LAUNDER(xtx); LAUNDER(bgr); LAUNDER(xtwr); LAUNDER(sbw); LAUNDER(scq); LAUNDER(sct); LAUNDER(scs);
#pragma unroll
        for (int i = 0; i < 4; ++i) { *(LAS u32x4*)(bsw + i * 32 * 136) = breg[i]; *(LAS u32x4*)(bsw + (SD_CS - SD_BS) / 2 + i * 32 * 136) = creg[i]; }
#pragma unroll
        for (int i = 0; i < 2; ++i) { const float we = scs[256 + 64 * i];
#pragma unroll
            for (int e = 0; e < 8; ++e) { const unsigned word = xreg[i][e >> 1]; const unsigned raw = (e & 1) ? (word >> 16) : (word & 0xffffu);
                xtw_[e * 136 + 64 * i] = (bf16)raw; xtw_[(SD_XTW - SD_XT) / 2 + e * 136 + 64 * i] = f2bf(bf2f(raw) * we); } }
        const char* zp_ = pz0 + (size_t)c * 128 * LDP * 2 + zoff;
        const u32x2 zr0 = *(const u32x2*)zp_, zr1 = *(const u32x2*)(zp_ + 32), zr2 = *(const u32x2*)(zp_ + 64), zr3 = *(const u32x2*)(zp_ + 96);
        __syncthreads();
        {
            const float bt = sct[0];
            bf16x8 cf[4];
#pragma unroll
            for (int kk = 0; kk < 4; ++kk) cf[kk] = *(const LAS bf16x8*)(csr + 32 * kk);
            bf16x8 af[4];
#pragma unroll
            for (int p = 0; p < 4; ++p) { u32x4 pw;
#pragma unroll
                for (int hf = 0; hf < 2; ++hf) { const int sb = 2 * p + hf; f32x4 sa = (f32x4){0.f, 0.f, 0.f, 0.f};
                    if (sb <= w) {
#pragma unroll
                        for (int kk = 0; kk < 4; ++kk) { const bf16x8 bfg = *(const LAS bf16x8*)(bsr + (16 * sb) * 136 + 32 * kk); sa = mfma16(bfg, cf[kk], sa); } }
                    float v[4]; const f32x4 b4 = *(const LAS f32x4*)(scq + 16 * sb), d4 = *(const LAS f32x4*)(scq + 128 + 16 * sb);
#pragma unroll
                    for (int i = 0; i < 4; ++i) { const int s = 16 * sb + 4 * fq + i; v[i] = (sb <= w && s <= t) ? sa[i] * __expf(bt - b4[i]) * d4[i] : 0.f; }
                    pw[2 * hf] = pk_bf16(v[0], v[1]); pw[2 * hf + 1] = pk_bf16(v[2], v[3]); }
                af[p] = __builtin_bit_cast(bf16x8, pw); }
            const float ebt = __expf(bt);
            float ss = 0.f;
#pragma unroll
            for (int pb = 0; pb < 4; ++pb) { f32x4 yacc = (f32x4){0.f, 0.f, 0.f, 0.f}, y2 = yacc;
#pragma unroll
                for (int p = 0; p < 4; ++p) if (2 * p <= w) { const LAS bf16* xp = xtr + (16 * pb) * 136 + 32 * p;
                    const u32x2 lo = *(const LAS u32x2*)xp, hi = *(const LAS u32x2*)(xp + 16); u32x4 vv; vv.x = lo.x; vv.y = lo.y; vv.z = hi.x; vv.w = hi.y;
                    yacc = mfma16(__builtin_bit_cast(bf16x8, vv), af[p], yacc); }
#pragma unroll
                for (int kk = 0; kk < 4; ++kk) { const bf16x8 sf = *(const LAS bf16x8*)(sbr + (16 * pb) * 136 + 32 * kk); y2 = mfma16(sf, cf[kk], y2); }
                const u32x2 zr = pb == 0 ? zr0 : (pb == 1 ? zr1 : (pb == 2 ? zr2 : zr3));
                f32x4 o;
#pragma unroll
                for (int i = 0; i < 4; ++i) { const float xv = bf2f(xtx[(16 * pb + i) * 136]); const unsigned zw = zr[i >> 1]; const float z = (i & 1) ? __uint_as_float(zw & 0xffff0000u) : __uint_as_float(zw << 16);
                    const float y = yacc[i] + ebt * y2[i] + Dk * xv; o[i] = y * silu_f(z); ss += o[i] * o[i]; }
                { u32x2 ow_; ow_.x = pk_bf16(o[0], o[1]); ow_.y = pk_bf16(o[2], o[3]); *(u32x2*)(py0 + (size_t)c * 128 * DM * 2 + 32 * pb + yoff) = ow_; } }
            ss += __shfl_xor(ss, 16); ss += __shfl_xor(ss, 32);
            if (fq == 0 && atom) atomicAdd(ssqB + (tok0 + t) * 2 + g, (u64)(ss * SSQ_SCALE));
        }
        if (w == 0 && c < 15) { float gz[2]; SD_LOAD_G(c + 1); ssd_scan(gz[0], gz[1], dtb, Aneg, lane, sn); }
        __syncthreads();
        {
            if (c < 15) SD_LOAD(c + 1);
            const float eb = sc[384];
#pragma unroll
            for (int pb = 0; pb < 4; ++pb) Sacc[pb] = Sacc[pb] * eb;
#pragma unroll
            for (int p = 0; p < 4; ++p) { const s16x4 b0 = lds_tr4(bgr + (32 * p) * 136), b1 = lds_tr4(bgr + (32 * p + 4) * 136);
                const bf16x8 btf = (bf16x8){b0[0], b0[1], b0[2], b0[3], b1[0], b1[1], b1[2], b1[3]};
#pragma unroll
                for (int pb = 0; pb < 4; ++pb) { const bf16x8 xf = *(const LAS bf16x8*)(xtwr + (16 * pb) * 136 + 32 * p); Sacc[pb] = mfma16(btf, xf, Sacc[pb]); } }
#pragma unroll
            for (int pb = 0; pb < 4; ++pb) { u32x2 o; o.x = pk_bf16(Sacc[pb][0], Sacc[pb][1]); o.y = pk_bf16(Sacc[pb][2], Sacc[pb][3]); *(LAS u32x2*)(sbw + (16 * pb) * 136) = o; }
        }
        __syncthreads();
    }
#undef SD_LOAD
#undef SD_LOAD_G
#pragma unroll
    for (int pb = 0; pb < 4; ++pb) *(f32x4*)(pS + (((size_t)b * 32 + head) * 64 + 16 * pb + fr) * 128 + 16 * w + 4 * fq) = Sacc[pb];
    __syncthreads();
}

DI void mlstm_decode_unit(LAS unsigned char* lds, int unit, const bf16* proj, const float* gsm, const float* i_bias, const float* f_bias,
                          const float* stC, const float* stn, const float* stm, bf16* hml, u64* ssqA, float* sC, float* sn, float* sm, bool atom) {
    int tid_ = threadIdx.x; asm volatile("" : "+v"(tid_)); const int tid = tid_, lane = tid & 63, w = __builtin_amdgcn_readfirstlane(tid >> 6);
    const int bs = unit >> 2, h = unit & 3; const size_t R = (size_t)NPROMPT + bs;
    LAS float* qs = (LAS float*)lds; LAS float* ks = qs + 256; LAS float* vs = ks + 256; LAS float* ns = vs + 512; LAS float* red = ns + 256; LAS f32x4* red4 = (LAS f32x4*)(red + 64);
    if (tid < 256) { qs[tid] = bf2f(proj[R * LDP + PQ + h * 256 + tid]); ks[tid] = bf2f(proj[R * LDP + PK + h * 256 + tid]); ns[tid] = stn[(size_t)unit * 256 + tid]; }
    vs[tid] = bf2f(proj[R * LDP + PV + h * 512 + tid]);
    __syncthreads();
    { float pqk = 0.f, pqn = 0.f; if (tid < 256) { pqk = qs[tid] * ks[tid]; pqn = qs[tid] * ns[tid]; }
      pqk = wave_sum(pqk); pqn = wave_sum(pqn); if (lane == 0) { red[w] = pqk; red[8 + w] = pqn; } }
    __syncthreads();
    const float qk = (red[0] + red[1]) + (red[2] + red[3]), qn = (red[8] + red[9]) + (red[10] + red[11]);
    const float li = gsm[R * 64 + h] + i_bias[h], lf = log_sigmoid(gsm[R * 64 + 4 + h] + f_bias[h]), m0 = stm[unit];
    const float mt = fmaxf(lf + m0, li), wi = __expf(li - mt), wo = __expf(lf + m0 - mt);
    const float sv = qk * wi, den = sv + wo * qn, inv = 1.0f / fmaxf(fabsf(den), __expf(-mt));
    const int col4 = tid & 127, dg = tid >> 7;
    const f32x4* Cin = (const f32x4*)(stC + (size_t)unit * 131072); f32x4* Cout = (f32x4*)(sC + (size_t)unit * 131072);
    const f32x4 v4 = *(const LAS f32x4*)(vs + 4 * col4);
    f32x4 acc = (f32x4){0.f, 0.f, 0.f, 0.f};
#pragma unroll 1
    for (int it = 0; it < 64; it += 8) { f32x4 cv[8];
#pragma unroll
        for (int u = 0; u < 8; ++u) cv[u] = __builtin_nontemporal_load(Cin + (size_t)(4 * (it + u) + dg) * 128 + col4);
#pragma unroll
        for (int u = 0; u < 8; ++u) { const int d = 4 * (it + u) + dg; const float qd = qs[d], kd = ks[d] * wi; acc += cv[u] * qd;
            __builtin_nontemporal_store(cv[u] * wo + v4 * kd, Cout + (size_t)d * 128 + col4); } }
    red4[dg * 128 + col4] = acc;
    __syncthreads();
    float ss = 0.f;
    if (dg == 0) { const f32x4 tot = (red4[col4] + red4[128 + col4]) + (red4[256 + col4] + red4[384 + col4]);
        const f32x4 hv = (v4 * sv + tot * wo) * inv; ss = (hv[0] * hv[0] + hv[1] * hv[1]) + (hv[2] * hv[2] + hv[3] * hv[3]);
        { u32x2 hw_; hw_.x = pk_bf16(hv[0], hv[1]); hw_.y = pk_bf16(hv[2], hv[3]); *(u32x2*)(hml + R * DM + h * 512 + 4 * col4) = hw_; } }
    ss = wave_sum(ss);
    if (lane == 0 && w < 2 && atom) atomicAdd(ssqA + R * 4 + h, (u64)(ss * SSQ_SCALE));
    if (tid < 256) sn[(size_t)unit * 256 + tid] = wo * ns[tid] + wi * ks[tid];
    if (tid == 0) sm[unit] = mt;
    __syncthreads();
}
DI void ssd_decode_unit(LAS unsigned char* lds, int unit, const bf16* proj, const bf16* XA, const float* gsm, const float* dt_bias, const float* A_log, const float* Dsk,
                        const float* stS, bf16* ys, u64* ssqB, float* sS, bool atom) {
    int tid_ = threadIdx.x; asm volatile("" : "+v"(tid_)); const int tid = tid_, lane = tid & 63, w = __builtin_amdgcn_readfirstlane(tid >> 6);
    const int bs = unit >> 2, head = 8 * (unit & 3) + w, g = head >> 4; const size_t R = (size_t)NPROMPT + bs;
    LAS float* xs = (LAS float*)(lds + w * 2048); LAS float* Bv = xs + 64; LAS float* Cv = Bv + 128;
    const bf16* xr = XA + R * XBC;
    xs[lane] = bf2f(xr[head * 64 + lane]);
    Bv[lane] = bf2f(xr[2048 + g * 128 + lane]); Bv[lane + 64] = bf2f(xr[2048 + g * 128 + 64 + lane]);
    Cv[lane] = bf2f(xr[2304 + g * 128 + lane]); Cv[lane + 64] = bf2f(xr[2304 + g * 128 + 64 + lane]);
    asm volatile("s_waitcnt lgkmcnt(0)" ::: "memory");
    const float cbdot = wave_sum(Cv[lane] * Bv[lane] + Cv[lane + 64] * Bv[lane + 64]);
    const float dt = softplus_f(gsm[R * 64 + 8 + head] + dt_bias[head]), ea = __expf(-dt * __expf(A_log[head])), Dk = Dsk[head];
    const int n4 = lane & 31, prow = lane >> 5;
    const f32x4 B4 = *(const LAS f32x4*)(Bv + 4 * n4), C4 = *(const LAS f32x4*)(Cv + 4 * n4);
    const f32x4* Sin = (const f32x4*)(stS + ((size_t)bs * 32 + head) * 8192); f32x4* Sout = (f32x4*)(sS + ((size_t)bs * 32 + head) * 8192);
    float ss = 0.f;
#pragma unroll 1
    for (int it = 0; it < 32; it += 8) { f32x4 sv[8];
#pragma unroll
        for (int u = 0; u < 8; ++u) sv[u] = __builtin_nontemporal_load(Sin + (size_t)(2 * (it + u) + prow) * 32 + n4);
#pragma unroll
        for (int u = 0; u < 8; ++u) { const int p = 2 * (it + u) + prow; const float xp = xs[p];
            __builtin_nontemporal_store(sv[u] * ea + B4 * (dt * xp), Sout + (size_t)p * 32 + n4);
            float y2 = (C4[0] * sv[u][0] + C4[1] * sv[u][1]) + (C4[2] * sv[u][2] + C4[3] * sv[u][3]);
#pragma unroll
            for (int o = 1; o < 32; o <<= 1) y2 += __shfl_xor(y2, o);
            const float z = bf2f(proj[R * LDP + PZ + head * 64 + p]);
            const float yv = (cbdot * dt * xp + ea * y2 + Dk * xp) * silu_f(z);
            if (n4 == 0) { ys[R * DM + head * 64 + p] = f2bf(yv); ss += yv * yv; } } }
    ss += __shfl_xor(ss, 32);
    if (lane == 0 && atom) atomicAdd(ssqB + R * 2 + g, (u64)(ss * SSQ_SCALE));
}

DI void merge_phase(const Args& a, int vcu, int G) {
    int tid_ = threadIdx.x; asm volatile("" : "+v"(tid_)); const int tid = tid_, lane = tid & 63, wave = __builtin_amdgcn_readfirstlane(tid >> 6);
    unsigned char* ws = a.ws;
    const bf16* proj = (const bf16*)(ws + WS_PROJ); const bf16* hml = (const bf16*)(ws + WS_HML); const bf16* ys = (const bf16*)(ws + WS_YS);
    const u64* ssqA = (const u64*)(ws + WS_SSQ) + SSQA; const u64* ssqB = (const u64*)(ws + WS_SSQ) + SSQB;
    bf16* mg = (bf16*)(ws + WS_MERGED); const float* hnw = a.in[15]; const float* snw = a.in[21];
    const int gw = vcu * NWAVES + wave, NGW = G * NWAVES;
    for (int row = gw; row < NTOK; row += NGW) {
        float rA[4], rB[2];
#pragma unroll
        for (int i = 0; i < 4; ++i) rA[i] = rs_from(ssqA, row * 4 + i, 1.0f / 512.0f);
#pragma unroll
        for (int i = 0; i < 2; ++i) rB[i] = rs_from(ssqB, row * 2 + i, 1.0f / 1024.0f);
#pragma unroll
        for (int it = 0; it < 8; ++it) { const int c = 4 * lane + 256 * it;
            const u32x2 hr = *(const u32x2*)(hml + (size_t)row * DM + c), yr = *(const u32x2*)(ys + (size_t)row * DM + c); const f32x4 hw = *(const f32x4*)(hnw + c), sw = *(const f32x4*)(snw + c);
            const f32x4 hv = (f32x4){__uint_as_float(hr.x << 16), __uint_as_float(hr.x & 0xffff0000u), __uint_as_float(hr.y << 16), __uint_as_float(hr.y & 0xffff0000u)}, yv = (f32x4){__uint_as_float(yr.x << 16), __uint_as_float(yr.x & 0xffff0000u), __uint_as_float(yr.y << 16), __uint_as_float(yr.y & 0xffff0000u)};
            const u32x2 og = *(const u32x2*)(proj + (size_t)row * LDP + POG + c), ga = *(const u32x2*)(proj + (size_t)row * LDP + PGATE + c), gb = *(const u32x2*)(proj + (size_t)row * LDP + PGATE + DM + c);
            float o[4];
#pragma unroll
            for (int i = 0; i < 4; ++i) { const unsigned ow = og[i >> 1], aw = ga[i >> 1], bw = gb[i >> 1];
                const float ogf = (i & 1) ? __uint_as_float(ow & 0xffff0000u) : __uint_as_float(ow << 16), gaf = (i & 1) ? __uint_as_float(aw & 0xffff0000u) : __uint_as_float(aw << 16), gbf = (i & 1) ? __uint_as_float(bw & 0xffff0000u) : __uint_as_float(bw << 16);
                o[i] = sigm_f(gaf) * (sigm_f(ogf) * hv[i] * rA[it >> 1] * hw[i]) + sigm_f(gbf) * (yv[i] * rB[it >> 2] * sw[i]); }
            u32x2 wv; wv.x = pk_bf16(o[0], o[1]); wv.y = pk_bf16(o[2], o[3]); *(u32x2*)(mg + (size_t)row * DM + c) = wv; }
    }
    float* out = a.out; const int gt = vcu * NTHR + tid, NGT = G * NTHR;
    for (int i = gt; i < NBATCH * 3 * XBC; i += NGT) { const int ch = i % XBC, r = (i / XBC) % 3, b = i / (3 * XBC); out[O_PCONV + i] = bf2f(proj[((size_t)b * SEQ + SEQ - 3 + r) * LDP + PXBC + ch]); }
    const float* stc = a.in[2];
    for (int i = gt; i < NSAMP * 3 * XBC; i += NGT) { const int ch = i % XBC, r = (i / XBC) % 3, bs = i / (3 * XBC);
        out[O_SCONV + i] = r < 2 ? stc[(size_t)bs * 3 * XBC + (r + 1) * XBC + ch] : bf2f(proj[((size_t)NPROMPT + bs) * LDP + PXBC + ch]); }
}
DI void final_norm_phase(const Args& a, int vcu, int G) {
    int tid_ = threadIdx.x; asm volatile("" : "+v"(tid_)); const int tid = tid_, lane = tid & 63, wave = __builtin_amdgcn_readfirstlane(tid >> 6);
    const u64* ssq3 = (const u64*)(a.ws + WS_SSQ) + SSQ3; const float* fw = a.in[27]; float* out = a.out; const bf16* xb = (const bf16*)(a.ws + WS_XB);
    const int gw = vcu * NWAVES + wave, NGW = G * NWAVES;
    for (int row = gw; row < NTOK; row += NGW) { const float r = rs_from(ssq3, row, 1.0f / 2048.0f);
#pragma unroll
        for (int it = 0; it < 4; ++it) { const int c = 8 * lane + 512 * it; const u32x4 xr = *(const u32x4*)(xb + (size_t)row * DM + c);
            const f32x4 f0 = *(const f32x4*)(fw + c), f1 = *(const f32x4*)(fw + c + 4);
            const f32x4 v0 = (f32x4){__uint_as_float(xr.x << 16), __uint_as_float(xr.x & 0xffff0000u), __uint_as_float(xr.y << 16), __uint_as_float(xr.y & 0xffff0000u)};
            const f32x4 v1 = (f32x4){__uint_as_float(xr.z << 16), __uint_as_float(xr.z & 0xffff0000u), __uint_as_float(xr.w << 16), __uint_as_float(xr.w & 0xffff0000u)};
            *(f32x4*)(out + (size_t)row * DM + c) = v0 * r * f0; *(f32x4*)(out + (size_t)row * DM + c + 4) = v1 * r * f1; } }
}

template <int KSTEPS>
DI void gemm_skinny(LAS unsigned char* lds, int c, const bf16* A, const bf16* Bt, const float* res, const bf16* resb, float alpha, float* out, bf16* xb, u64* ssq) {
    int tid_ = threadIdx.x; asm volatile("" : "+v"(tid_)); const int tid = tid_, lane = tid & 63, w = __builtin_amdgcn_readfirstlane(tid >> 6), fr = lane & 15, fq = lane >> 4;
    constexpr int K = KSTEPS * 256, kw = K / 8;
    const int cb = c >> 1, r0 = 64 * (c & 1);
    const bf16* ap = A + (size_t)(NPROMPT + r0 + fr) * K + w * kw + 8 * fq;
    const bf16* bp = Bt + (size_t)(16 * cb + fr) * K + w * kw + 8 * fq;
    f32x4 acc[4];
#pragma unroll
    for (int rb = 0; rb < 4; ++rb) acc[rb] = (f32x4){0.f, 0.f, 0.f, 0.f};
#pragma unroll
    for (int k0 = 0; k0 < KSTEPS; k0 += 8) { bf16x8 bfg[8], af[8][4];
#pragma unroll
        for (int u = 0; u < 8; ++u) if (k0 + u < KSTEPS) { bfg[u] = *(const bf16x8*)(bp + 32 * (k0 + u));
#pragma unroll
            for (int rb = 0; rb < 4; ++rb) af[u][rb] = *(const bf16x8*)(ap + (size_t)rb * 16 * K + 32 * (k0 + u)); }
#pragma unroll
        for (int u = 0; u < 8; ++u) if (k0 + u < KSTEPS) {
#pragma unroll
            for (int rb = 0; rb < 4; ++rb) acc[rb] = mfma16(bfg[u], af[u][rb], acc[rb]); } }
    LAS f32x4* red = (LAS f32x4*)lds;
#pragma unroll
    for (int rb = 0; rb < 4; ++rb) red[(w * 4 + rb) * 64 + lane] = acc[rb];
    __syncthreads();
    if (w < 4) {
        f32x4 sum = red[w * 64 + lane];
#pragma unroll
        for (int w2 = 1; w2 < 8; ++w2) sum += red[(w2 * 4 + w) * 64 + lane];
        const int rl = r0 + 16 * w + fr, col = 16 * cb + 4 * fq;
        f32x4 rv;
        if (res) rv = *(const f32x4*)(res + (size_t)rl * DM + col);
        else { const u32x2 rw = *(const u32x2*)(resb + (size_t)(NPROMPT + rl) * DM + col); rv = (f32x4){__uint_as_float(rw.x << 16), __uint_as_float(rw.x & 0xffff0000u), __uint_as_float(rw.y << 16), __uint_as_float(rw.y & 0xffff0000u)}; }
        const f32x4 o = rv + sum * alpha;
        if (out) *(f32x4*)(out + (size_t)rl * DM + col) = o;
        if (xb) { u32x2 wv; wv.x = pk_bf16(o[0], o[1]); wv.y = pk_bf16(o[2], o[3]); *(u32x2*)(xb + (size_t)(NPROMPT + rl) * DM + col) = wv; }
        float ss = (o[0] * o[0] + o[1] * o[1]) + (o[2] * o[2] + o[3] * o[3]);
        ss += __shfl_xor(ss, 16); ss += __shfl_xor(ss, 32);
        if (fq == 0) atomicAdd(ssq + NPROMPT + rl, (u64)(ss * SSQ_SCALE));
    }
    __syncthreads();
}

#define XB_TMO      128
#define XB_XCNT(j)  (256  + 64 * (j))
#define XB_XSUB(j)  (1280 + 64 * (j))
#define XB_XGEN(j)  (2304 + 64 * (j))
#define XB_TOP      3328
#define XB_TOPGEN   3392
#define XCD_BAR_WORDS 3456
#define XB_SPIN_CAP (1u << 18)

__device__ __forceinline__ unsigned xb_ld(unsigned* p)              { return __hip_atomic_load(p, __ATOMIC_RELAXED, __HIP_MEMORY_SCOPE_AGENT); }
__device__ __forceinline__ unsigned xb_add(unsigned* p, unsigned v) { return __hip_atomic_fetch_add(p, v, __ATOMIC_RELAXED, __HIP_MEMORY_SCOPE_AGENT); }
__device__ __forceinline__ unsigned xb_xcc_id() { return (unsigned)__builtin_amdgcn_s_getreg((3 << 11) | 20) & 0xFu; }
#define XB_SPIN(cond, bar) do { unsigned _sp = 0; while (cond) { __builtin_amdgcn_s_sleep(1); \
    if ((++_sp & 255u) == 0u) { if (xb_ld(&(bar)[XB_TMO])) break; if (_sp > XB_SPIN_CAP) { atomicAdd(&(bar)[XB_TMO], 1u); break; } } } } while (0)

struct XcdBarrier {
    unsigned* bar; unsigned x;
    volatile LAS unsigned* st;
};

__device__ __forceinline__ XcdBarrier xcd_barrier_post(unsigned* bar, volatile LAS unsigned* st) {
    XcdBarrier b; b.bar = bar; b.x = xb_xcc_id(); b.st = st;
    if (threadIdx.x == 0) (void)xb_add(&bar[XB_XCNT(b.x)], 1u);
    return b;
}
__device__ __forceinline__ void xcd_barrier_complete(unsigned* bar, unsigned x, unsigned& nloc, unsigned& nx) {
    const unsigned G = gridDim.x * gridDim.y * gridDim.z;
    unsigned sum, cnt, mine, sp = 0u;
    for (;;) {
        sum = 0u; cnt = 0u; mine = 0u;
#pragma unroll
        for (unsigned j = 0; j < 16; ++j) { const unsigned c = xb_ld(&bar[XB_XCNT(j)]); sum += c; cnt += (c > 0u) ? 1u : 0u; mine = (j == x) ? c : mine; }
        if (sum == G) break;
        __builtin_amdgcn_s_sleep(1);
        if ((++sp & 255u) == 0u) { if (xb_ld(&bar[XB_TMO])) break; if (sp > XB_SPIN_CAP) { atomicAdd(&bar[XB_TMO], 1u); break; } }
    }
    nloc = mine > 0u ? mine : 1u; nx = cnt > 0u ? cnt : 1u;
}

__device__ __forceinline__ void xcd_barrier(const XcdBarrier& b) {
    asm volatile("s_waitcnt vmcnt(0)" ::: "memory");
    __syncthreads();
    if (threadIdx.x == 0) {
        unsigned* bar = b.bar;
        __builtin_amdgcn_s_waitcnt(0);
        unsigned nloc = b.st[0], nx = b.st[1];
        if (nloc == 0u) { xcd_barrier_complete(bar, b.x, nloc, nx); b.st[0] = nloc; b.st[1] = nx; }
        const unsigned old = xb_add(&bar[XB_XSUB(b.x)], 1u);
        const unsigned gen = old / nloc;
        if (old + 1u == (gen + 1u) * nloc) {
            __builtin_amdgcn_fence(__ATOMIC_RELEASE, "agent");
            asm volatile("s_waitcnt vmcnt(0)" ::: "memory");
            const unsigned og = xb_add(&bar[XB_TOP], 1u);
            const unsigned tg = og / nx;
            if (og + 1u == (tg + 1u) * nx) xb_add(&bar[XB_TOPGEN], 1u);
            else XB_SPIN(xb_ld(&bar[XB_TOPGEN]) == tg, bar);
            __builtin_amdgcn_fence(__ATOMIC_ACQUIRE, "agent");
            xb_add(&bar[XB_XGEN(b.x)], 1u);
            asm volatile("s_waitcnt vmcnt(0)" ::: "memory");
        } else {
            XB_SPIN(xb_ld(&bar[XB_XGEN(b.x)]) == gen, bar);
            __builtin_amdgcn_fence(__ATOMIC_ACQUIRE, "agent");
            asm volatile("s_waitcnt vmcnt(0)" ::: "memory");
        }
    }
    __syncthreads();
}


__global__ void __launch_bounds__(NTHR, 2) hybrid_fwd(Args a) {
    extern __shared__ __attribute__((aligned(16))) unsigned char lds_raw[];
    LAS unsigned char* lds = (LAS unsigned char*)lds_raw;
    cg::grid_group grid = cg::this_grid();
    const int G = gridDim.x, bx = blockIdx.x;
    const int vcu = (G % 8 == 0) ? (bx % 8) * (G / 8) + bx / 8 : bx;
    unsigned char* ws = a.ws;
    volatile LAS unsigned* bst = (volatile LAS unsigned*)(lds + LDS_BYTES - 16);
    if (threadIdx.x < 4) bst[threadIdx.x] = 0u;
    __syncthreads();
    XcdBarrier xbar = xcd_barrier_post((unsigned*)(ws + WS_BAR), bst);
    u64* ssq = (u64*)(ws + WS_SSQ);
    bf16* xb = (bf16*)(ws + WS_XB); bf16* Hb = (bf16*)(ws + WS_H); bf16* proj = (bf16*)(ws + WS_PROJ); bf16* mg = (bf16*)(ws + WS_MERGED);
    float* gsm = (float*)(ws + WS_GSM); bf16* hml = (bf16*)(ws + WS_HML); bf16* ysb = (bf16*)(ws + WS_YS);

    if (a.out == nullptr) grid.sync();
    p0_prologue(lds, a, vcu, G);
    xcd_barrier(xbar);
    {
        pg8::Gemm g{xb, (const bf16*)(ws + WS_WGU1), MP, NGU, DM}; pg8::StaticOrder S; S.init(MP, NGU, G, bx);
        pg8::EpiSwiGLU E{Hb, FF, ssq + SSQ0};
        pg8::gemm_phase<pg8::EpiSwiGLU, pg8::StaticOrder, true, true>(lds, g, S, E);
        { const int nfull = (MP / 256) * (NGU / 256) % G;
          if (nfull && bx >= nfull) convert_items(lds, a, CV_PROLOGUE_END, CV_G1TAIL_END, (bx - nfull) * NWAVES + __builtin_amdgcn_readfirstlane((int)(threadIdx.x >> 6)), (G - nfull) * NWAVES); }
    }
    xcd_barrier(xbar);
    {
        pg8::Gemm g{Hb, (const bf16*)(ws + WS_WD1), NPROMPT, DM, FF}; pg8::StaticOrder S; S.init(NPROMPT, DM, G, bx);
        pg8::EpiResid E{nullptr, xb, nullptr, xb, ssq + SSQ1, 0.5f};
        pg8::gemm_phase<pg8::EpiResid, pg8::StaticOrder, true, true>(lds, g, S, E);
        for (int c = vcu; c < 256; c += G) gemm_skinny<FF / 256>(lds, c, Hb, (const bf16*)(ws + WS_WD1), nullptr, xb, 0.5f, nullptr, xb, ssq + SSQ1);
    }
    xcd_barrier(xbar);
    {
        pg8::Gemm g{xb, (const bf16*)(ws + WS_WIN), MP, NPROJ, DM}; pg8::StaticOrder S; S.init(MP, NPROJ, G, bx);
        pg8::EpiProj E{proj, LDP, gsm, ssq + SSQ1, LDP / 256};
        pg8::gemm_phase<pg8::EpiProj, pg8::StaticOrder, true, true>(lds, g, S, E);
        { const int nfull = (MP / 256) * (NPROJ / 256) % G;
          if (nfull && bx >= nfull) convert_items(lds, a, CV_G1TAIL_END, CV_END, (bx - nfull) * NWAVES + __builtin_amdgcn_readfirstlane((int)(threadIdx.x >> 6)), (G - nfull) * NWAVES); }
    }
    xcd_barrier(xbar);
    {
        float* out = a.out; const bf16* XA = (const bf16*)(ws + WS_XA);
        unsigned* qctr = (unsigned*)(ws + WS_BAR) + XCD_BAR_WORDS;
        const bool split = (G == 256);
        bool conv_seen = !split;
        if (!split) { conv_pass(a, vcu, G); xcd_barrier(xbar); }
        else if (vcu >= 128) {
            conv_pass(a, vcu - 128, 128);
            asm volatile("s_waitcnt vmcnt(0)" ::: "memory"); __syncthreads();
            if (threadIdx.x == 0) { __builtin_amdgcn_fence(__ATOMIC_RELEASE, "agent"); asm volatile("s_waitcnt vmcnt(0)" ::: "memory");
                __hip_atomic_fetch_add(qctr + 32, 1u, __ATOMIC_RELAXED, __HIP_MEMORY_SCOPE_AGENT); }
        }
#define WAIT_CONV() do { if (!conv_seen) { if (threadIdx.x == 0) { unsigned sp_ = 0u; \
            while (__hip_atomic_load(qctr + 32, __ATOMIC_RELAXED, __HIP_MEMORY_SCOPE_AGENT) < 128u) { __builtin_amdgcn_s_sleep(2); if (++sp_ > (1u << 22)) break; } \
            __builtin_amdgcn_fence(__ATOMIC_ACQUIRE, "agent"); asm volatile("s_waitcnt vmcnt(0)" ::: "memory"); } \
            __syncthreads(); conv_seen = true; } } while (0)
        for (int u = vcu; u < 256; u += G) {
            if (u < 128) mlstm_prompt_unit(lds, u, proj, gsm, a.in[13], a.in[14], hml, ssq + SSQA, out + O_PC, out + O_PN, out + O_PM, true);
            else { WAIT_CONV(); ssd_prompt_unit(lds, u - 128, proj, XA, gsm, a.in[18], a.in[19], a.in[20], ysb, ssq + SSQB, out + O_PSSM, true); } }
        for (;;) {
            if (threadIdx.x == 0) bst[2] = atomicAdd(qctr, 1u);
            __syncthreads();
            const int u = (int)bst[2];
            __syncthreads();
            if (u >= 1024) break;
            if (u < 512) mlstm_decode_unit(lds, u, proj, gsm, a.in[13], a.in[14], a.in[3], a.in[4], a.in[5], hml, ssq + SSQA, out + O_SC, out + O_SN, out + O_SM, true);
            else { WAIT_CONV(); ssd_decode_unit(lds, u - 512, proj, XA, gsm, a.in[18], a.in[19], a.in[20], a.in[6], ysb, ssq + SSQB, out + O_SSSM, true); }
        }
#undef WAIT_CONV
    }
    xcd_barrier(xbar);
    merge_phase(a, vcu, G);
    xcd_barrier(xbar);
    {
        pg8::Gemm g{mg, (const bf16*)(ws + WS_WOUT), NPROMPT, DM, DM}; pg8::StaticOrder S; S.init(NPROMPT, DM, G, bx);
        pg8::EpiResid E{nullptr, xb, nullptr, xb, ssq + SSQ2, 1.0f};
        pg8::gemm_phase<pg8::EpiResid, pg8::StaticOrder, true, true>(lds, g, S, E);
        for (int c = vcu; c < 256; c += G) gemm_skinny<DM / 256>(lds, c, mg, (const bf16*)(ws + WS_WOUT), nullptr, xb, 1.0f, nullptr, xb, ssq + SSQ2);
    }
    xcd_barrier(xbar);
    {
        pg8::Gemm g{xb, (const bf16*)(ws + WS_WGU2), MP, NGU, DM}; pg8::StaticOrder S; S.init(MP, NGU, G, bx);
        pg8::EpiSwiGLU E{Hb, FF, ssq + SSQ2};
        pg8::gemm_phase<pg8::EpiSwiGLU, pg8::StaticOrder, true, true>(lds, g, S, E);
    }
    xcd_barrier(xbar);
    {
        pg8::Gemm g{Hb, (const bf16*)(ws + WS_WD2), NPROMPT, DM, FF}; pg8::StaticOrder S; S.init(NPROMPT, DM, G, bx);
        pg8::EpiResid E{nullptr, xb, nullptr, xb, ssq + SSQ3, 0.5f};
        pg8::gemm_phase<pg8::EpiResid, pg8::StaticOrder, true, true>(lds, g, S, E);
        for (int c = vcu; c < 256; c += G) gemm_skinny<FF / 256>(lds, c, Hb, (const bf16*)(ws + WS_WD2), nullptr, xb, 0.5f, nullptr, xb, ssq + SSQ3);
    }
    xcd_barrier(xbar);
    final_norm_phase(a, vcu, G);
}

extern "C" void kernel_launch(void* const* d_in, const int* in_sizes, int n_in, void* d_out, int out_size, void* d_ws, size_t ws_size, hipStream_t stream) {
    static int grid = 0;
    if (grid == 0) {
        if (n_in != 28 || ws_size < WS_END) { fprintf(stderr, "kernel_launch: unexpected inputs (n_in %d, ws %zu)\n", n_in, ws_size); grid = -1; return; }
        int dev = 0, cus = 0, per_cu = 0;
        hipGetDevice(&dev); hipDeviceGetAttribute(&cus, hipDeviceAttributeMultiprocessorCount, dev);
        if (hipFuncSetAttribute((const void*)hybrid_fwd, hipFuncAttributeMaxDynamicSharedMemorySize, LDS_BYTES) != hipSuccess) { fprintf(stderr, "kernel_launch: hipFuncSetAttribute failed\n"); grid = -1; return; }
        if (hipOccupancyMaxActiveBlocksPerMultiprocessor(&per_cu, (const void*)hybrid_fwd, NTHR, LDS_BYTES) != hipSuccess || per_cu < 1) { fprintf(stderr, "kernel_launch: occupancy query gave %d\n", per_cu); per_cu = 1; }
        (void)hipGetLastError();
        grid = cus * per_cu;
    }
    if (grid < 0) return;
    Args a{};
    for (int i = 0; i < 28; ++i) a.in[i] = (const float*)d_in[i];
    a.out = (float*)d_out; a.ws = (unsigned char*)d_ws;
    if (hipMemsetAsync((char*)d_ws + WS_BAR, 0, XCD_BAR_WORDS * 4 + 256, stream) != hipSuccess) { fprintf(stderr, "kernel_launch: memset of barrier words failed\n"); return; }
    void* args[] = {&a};
    hipError_t e = hipLaunchCooperativeKernel((const void*)hybrid_fwd, dim3(grid), dim3(NTHR), args, LDS_BYTES, stream);
    if (e != hipSuccess) fprintf(stderr, "kernel_launch: cooperative launch failed: %s (grid %d)\n", hipGetErrorString(e), grid);
}
```

```cpp
#include <hip/hip_runtime.h>
#include <hip/hip_cooperative_groups.h>
#include <cstdio>
#include <cstdint>
namespace cg = cooperative_groups;
#define DI __device__ __forceinline__
namespace pg8 {
#define PG8_LAS __attribute__((address_space(3)))
typedef unsigned short bf16_t;
typedef short bf16x8 __attribute__((ext_vector_type(8)));
typedef float f32x4 __attribute__((ext_vector_type(4)));
typedef unsigned u32x4 __attribute__((ext_vector_type(4)));
constexpr int BM = 256, BK = 64, HALF = 128, HTB = HALF * BK * 2  , STAGE_BYTES = 8 * HTB, NXCD = 8, WGM = 8;

__host__ __device__ __forceinline__ int lds_byte(int r, int c) { const int st = (r >> 4) * 2 + (c >> 5), rr = r & 15, cc = c & 31, ob = rr * 64 + cc * 2; return st * 1024 + (ob ^ (((ob >> 9) & 1) << 5)); }
__host__ __device__ __forceinline__ void stage_rc(int b, int& R, int& C) { const int st = b / 1024, sb = b % 1024, swz = sb ^ (((sb >> 9) & 1) << 5); R = (st >> 1) * 16 + swz / 64; C = (st & 1) * 32 + (swz % 64) / 2; }
__host__ __device__ __forceinline__ int perm32(int rho) { const int n = rho >> 4, i = rho & 15; return 8 * (i >> 2) + 4 * n + (i & 3); }

struct Unit { int pm, pn; };
struct Gemm { const bf16_t* A; const bf16_t* Bt; int M, N, K; };

struct StaticOrder {
    int nM, nN, nwg, G, c;
    __host__ __device__ void init(int M, int N, int G_, int c_) { nM = M / BM; nN = N / BM; nwg = nM * nN; G = G_; c = c_; }
    __host__ __device__ bool next(int i, Unit& u) const {
        const long L = (long)i * G + c; if (L >= nwg) return false;
        int wgid = (int)L; { const int q = nwg / NXCD, r = nwg % NXCD, xcd = wgid % NXCD, off = wgid / NXCD; wgid = (xcd < r ? xcd * (q + 1) : r * (q + 1) + (xcd - r) * q) + off; }
        const int nig = WGM * nN, gid = wgid / nig, fm = gid * WGM, gsz = (nM - fm) < WGM ? (nM - fm) : WGM;
        u.pm = fm + ((wgid % nig) % gsz); u.pn = (wgid % nig) / gsz; return true;
    }
    __device__ __forceinline__ void a_ready(const Unit&) const {}
    __device__ __forceinline__ void done(const Unit&) const {}
};

typedef unsigned u32x2 __attribute__((ext_vector_type(2)));
__device__ __forceinline__ unsigned pk_bf16(float lo, float hi) {
    typedef __bf16 bfx2 __attribute__((ext_vector_type(2))); typedef float fx2 __attribute__((ext_vector_type(2)));
    fx2 v = {lo, hi}; return __builtin_bit_cast(unsigned, __builtin_convertvector(v, bfx2));
}
constexpr float SSQ_SCALE = 4294967296.0f;
__device__ __forceinline__ float rs_from(const unsigned long long* ssq, int row, float inv_n) { return rsqrtf((float)ssq[row] * (inv_n / SSQ_SCALE) + 1e-6f); }
__device__ __forceinline__ float silu_f(float g) { return g * __builtin_amdgcn_rcpf(1.0f + __expf(-g)); }
__device__ __forceinline__ float sigm_f(float g) { return __builtin_amdgcn_rcpf(1.0f + __expf(-g)); }

struct EpiSwiGLU {
    static constexpr bool PERM = true, AFTER_DRAIN = false;
    bf16_t* H; int ldh; const unsigned long long* ssq;
    __device__ __forceinline__ void operator()(const f32x4 (&acc)[2][2][4][2], const Unit& u, int wr, int wc, int fr, int fq) const {
        const int row0 = u.pm * BM + wr * 64 + fr, col0 = u.pn * HALF + wc * 32 + 8 * fq;
#pragma unroll
        for (int ai = 0; ai < 2; ++ai)
#pragma unroll
            for (int m = 0; m < 4; ++m) {
                const int row = row0 + ai * HALF + m * 16; const float r = rs_from(ssq, row, 1.0f / 2048.0f);
                typedef float f32x2 __attribute__((ext_vector_type(2)));
                const float r2 = r * r, rk = r * -1.4426950408889634f;
                u32x4 w;
#pragma unroll
                for (int q = 0; q < 4; ++q) { const int n = q >> 1, i0 = 2 * (q & 1);
                    const f32x2 ag = (f32x2){acc[ai][0][m][n][i0], acc[ai][0][m][n][i0 + 1]}, au = (f32x2){acc[ai][1][m][n][i0], acc[ai][1][m][n][i0 + 1]};
                    const f32x2 t = ag * rk; f32x2 ex; ex.x = __builtin_amdgcn_exp2f(t.x); ex.y = __builtin_amdgcn_exp2f(t.y);
                    const f32x2 d = ex + 1.0f; f32x2 rc; rc.x = __builtin_amdgcn_rcpf(d.x); rc.y = __builtin_amdgcn_rcpf(d.y);
                    const f32x2 hh = ((ag * au) * r2) * rc;
                    w[q] = pk_bf16(hh.x, hh.y); }
                *(u32x4*)(H + (size_t)row * ldh + col0) = w;
            }
    }
};
struct EpiResid {
    static constexpr bool PERM = false, AFTER_DRAIN = false;
    const float* res0; const bf16_t* resb; float* out; bf16_t* xb; unsigned long long* ssq; float alpha;
    __device__ __forceinline__ void operator()(const f32x4 (&acc)[2][2][4][2], const Unit& u, int wr, int wc, int fr, int fq) const {
        const int row0 = u.pm * BM + wr * 64 + fr, col0 = u.pn * BM + wc * 32 + 4 * fq;
#pragma unroll
        for (int ai = 0; ai < 2; ++ai)
#pragma unroll
            for (int m = 0; m < 4; ++m) {
                const int row = row0 + ai * HALF + m * 16;
                float ss = 0.f;
#pragma unroll
                for (int bj = 0; bj < 2; ++bj)
#pragma unroll
                    for (int n = 0; n < 2; ++n) {
                        const size_t off = (size_t)row * 2048 + col0 + bj * HALF + n * 16;
                        f32x4 rv;
                        if (res0) rv = *(const f32x4*)(res0 + off);
                        else { const u32x2 rw = *(const u32x2*)(resb + off); rv = (f32x4){__uint_as_float(rw.x << 16), __uint_as_float(rw.x & 0xffff0000u), __uint_as_float(rw.y << 16), __uint_as_float(rw.y & 0xffff0000u)}; }
                        const f32x4 o = rv + acc[ai][bj][m][n] * alpha;
                        ss += (o[0] * o[0] + o[1] * o[1]) + (o[2] * o[2] + o[3] * o[3]);
                        if (out) *(f32x4*)(out + off) = o;
                        if (xb) { u32x2 w; w.x = pk_bf16(o[0], o[1]); w.y = pk_bf16(o[2], o[3]); *(u32x2*)(xb + off) = w; }
                    }
                ss += __shfl_xor(ss, 16); ss += __shfl_xor(ss, 32);
                if (fq == 0) atomicAdd(ssq + row, (unsigned long long)(ss * SSQ_SCALE));
            }
    }
};
struct EpiProj {
    static constexpr bool PERM = true, AFTER_DRAIN = false;
    bf16_t* P; int ldp; float* gsm; const unsigned long long* ssq; int n_main;
    __device__ __forceinline__ void operator()(const f32x4 (&acc)[2][2][4][2], const Unit& u, int wr, int wc, int fr, int fq) const {
        const int row0 = u.pm * BM + wr * 64 + fr;
#pragma unroll
        for (int ai = 0; ai < 2; ++ai)
#pragma unroll
            for (int m = 0; m < 4; ++m) {
                const int row = row0 + ai * HALF + m * 16; const float r = rs_from(ssq, row, 1.0f / 2048.0f);
                if (u.pn < n_main) {
                    const int col0 = u.pn * BM + wc * 32 + 8 * fq;
#pragma unroll
                    for (int bj = 0; bj < 2; ++bj) { const f32x4 v0 = acc[ai][bj][m][0] * r, v1 = acc[ai][bj][m][1] * r;
                        u32x4 w; w.x = pk_bf16(v0[0], v0[1]); w.y = pk_bf16(v0[2], v0[3]); w.z = pk_bf16(v1[0], v1[1]); w.w = pk_bf16(v1[2], v1[3]);
                        *(u32x4*)(P + (size_t)row * ldp + col0 + bj * HALF) = w; }
                } else if (wc < 2) {
                    float* gp = gsm + (size_t)row * 64 + wc * 32 + 8 * fq;
                    *(f32x4*)gp = acc[ai][0][m][0] * r; *(f32x4*)(gp + 4) = acc[ai][0][m][1] * r;
                }
            }
    }
};

template <class Epi, class Sched, bool ALIGN_EPI = false, bool SP2 = false>
__device__ __forceinline__ void gemm_phase(PG8_LAS unsigned char* lds, const Gemm g, const Sched& S, const Epi& E) {
    int tid_ = threadIdx.x; asm volatile("" : "+v"(tid_)); const int tid = tid_, wid = __builtin_amdgcn_readfirstlane(tid >> 6), lane = tid & 63, wr = wid >> 2, wc = wid & 3, fr = lane & 15, fq = lane >> 4;
    const int K = g.K, nt = K / BK;
    unsigned voffA[2], voffB[2];
#pragma unroll
    for (int i = 0; i < 2; ++i) { int R, C; stage_rc(tid * 16 + i * 8192, R, C); const int Rb = Epi::PERM ? ((R & ~31) + perm32(R & 31)) : R;
        voffA[i] = (unsigned)(R * K + C) * 2u; voffB[i] = (unsigned)(Rb * K + C) * 2u; }
    const size_t kstep = (size_t)(BK * 2);
    const size_t hstep = (size_t)HALF * K * 2;
    const size_t tstep = 2 * hstep;
    const unsigned ldsw = (unsigned)wid * 1024u;
    const int aoff = lds_byte(wr * 64 + fr, fq * 8), boff = lds_byte(wc * 32 + fr, fq * 8);
#define PG8_SA(b, h) (((b) * 2 + (h)) * HTB)
#define PG8_SB(b, h) ((4 + (b) * 2 + (h)) * HTB)
#define PG8_STAGE(bufoff, gbase, voff) do { _Pragma("unroll") for (int _i = 0; _i < 2; ++_i) \
        __builtin_amdgcn_global_load_lds((const unsigned*)((const char*)(gbase) + (voff)[_i]), (PG8_LAS unsigned*)(lds + (bufoff) + ldsw + _i * 8192), 16, 0, 0); } while (0)
#define PG8_LDA(dst, b, h) do { _Pragma("unroll") for (int m = 0; m < 4; ++m) _Pragma("unroll") for (int k = 0; k < 2; ++k) dst[m][k] = *(const PG8_LAS bf16x8*)(lds + PG8_SA(b, h) + aoff + m * 2048 + k * 1024); } while (0)
#define PG8_LDB(dst, b, h) do { _Pragma("unroll") for (int n = 0; n < 2; ++n) _Pragma("unroll") for (int k = 0; k < 2; ++k) dst[n][k] = *(const PG8_LAS bf16x8*)(lds + PG8_SB(b, h) + boff + n * 2048 + k * 1024); } while (0)
#define PG8_MMA(ai, bj, At, Bt) do { __builtin_amdgcn_s_setprio(1); _Pragma("unroll") for (int m = 0; m < 4; ++m) _Pragma("unroll") for (int n = 0; n < 2; ++n) _Pragma("unroll") for (int k = 0; k < 2; ++k) \
        acc[ai][bj][m][n] = __builtin_amdgcn_mfma_f32_16x16x32_bf16(Bt[n][k], At[m][k], acc[ai][bj][m][n], 0, 0, 0); __builtin_amdgcn_s_setprio(0); } while (0)
#define PG8_WAIT_V(n) asm volatile("s_waitcnt vmcnt(" #n ")" ::: "memory")
#define PG8_WAIT_L(n) asm volatile("s_waitcnt lgkmcnt(" #n ")" ::: "memory")
#define PG8_BAR __builtin_amdgcn_s_barrier()
#define PG8_SCHED __builtin_amdgcn_sched_barrier(0)
    Unit cur, nxt; int ui = 0;
    if (!S.next(0, cur)) return;
    f32x4 acc[2][2][4][2];
#pragma unroll
    for (int a = 0; a < 2; ++a)
#pragma unroll
        for (int b = 0; b < 2; ++b)
#pragma unroll
            for (int m = 0; m < 4; ++m)
#pragma unroll
                for (int n = 0; n < 2; ++n) acc[a][b][m][n] = (f32x4){0.f, 0.f, 0.f, 0.f};
    bf16x8 At[4][2], B0[2][2], B1[2][2];
    const char* cA = (const char*)g.A + (size_t)cur.pm * tstep; const char* cB = (const char*)g.Bt + (size_t)cur.pn * tstep;
    S.a_ready(cur);
    if constexpr (SP2) {
        PG8_STAGE(PG8_SB(0, 0), cB, voffB); PG8_STAGE(PG8_SB(0, 1), cB + hstep, voffB); PG8_STAGE(PG8_SA(0, 0), cA, voffA); PG8_STAGE(PG8_SA(0, 1), cA + hstep, voffA);
        if (wr == 1) PG8_BAR;
        PG8_WAIT_V(2); PG8_BAR;
        PG8_STAGE(PG8_SB(1, 0), cB + kstep, voffB); PG8_STAGE(PG8_SA(1, 0), cA + kstep, voffA); PG8_STAGE(PG8_SB(1, 1), cB + hstep + kstep, voffB);
        PG8_WAIT_V(6); PG8_BAR;
    } else {
        PG8_STAGE(PG8_SB(0, 0), cB, voffB); PG8_STAGE(PG8_SA(0, 0), cA, voffA); PG8_STAGE(PG8_SB(0, 1), cB + hstep, voffB); PG8_STAGE(PG8_SA(0, 1), cA + hstep, voffA);
        if (wr == 1) PG8_BAR;
        PG8_WAIT_V(4); PG8_BAR;
        PG8_STAGE(PG8_SB(1, 0), cB + kstep, voffB); PG8_STAGE(PG8_SA(1, 0), cA + kstep, voffA); PG8_STAGE(PG8_SB(1, 1), cB + hstep + kstep, voffB);
        PG8_WAIT_V(6); PG8_BAR;
    }
    for (;;) {
        const bool has_next = S.next(ui + 1, nxt);
        const char* nA = has_next ? (const char*)g.A + (size_t)nxt.pm * tstep : cA; const char* nB = has_next ? (const char*)g.Bt + (size_t)nxt.pn * tstep : cB;
        for (int t = 0; t < nt; t += 2) {
            const bool last = (t == nt - 2);
            const char* a1 = cA + (size_t)(t + 1) * kstep;
            const char* a2 = last ? nA : cA + (size_t)(t + 2) * kstep; const char* b2 = last ? nB : cB + (size_t)(t + 2) * kstep;
            const char* a3 = a2 + kstep; const char* b3 = b2 + kstep;
            if (last && has_next) S.a_ready(nxt);
            if constexpr (SP2) {
            PG8_LDB(B0, 0, 0); PG8_LDB(B1, 0, 1); PG8_SCHED; PG8_LDA(At, 0, 0); PG8_STAGE(PG8_SA(1, 1), a1 + hstep, voffA);
            PG8_WAIT_V(8); PG8_WAIT_L(0); PG8_BAR; PG8_MMA(0, 0, At, B0); PG8_MMA(0, 1, At, B1); PG8_BAR; PG8_SCHED;
            PG8_LDA(At, 0, 1); PG8_STAGE(PG8_SB(0, 0), b2, voffB); PG8_STAGE(PG8_SB(0, 1), b2 + hstep, voffB); PG8_STAGE(PG8_SA(0, 0), a2, voffA);
            PG8_WAIT_V(8); PG8_WAIT_L(0); PG8_BAR; PG8_MMA(1, 0, At, B0); PG8_MMA(1, 1, At, B1); PG8_BAR; PG8_SCHED;
            PG8_LDB(B0, 1, 0); PG8_LDB(B1, 1, 1); PG8_SCHED; PG8_LDA(At, 1, 0); PG8_STAGE(PG8_SA(0, 1), a2 + hstep, voffA);
            PG8_WAIT_V(8); PG8_WAIT_L(0); PG8_BAR; PG8_MMA(0, 0, At, B0); PG8_MMA(0, 1, At, B1); PG8_BAR; PG8_SCHED;
            PG8_LDA(At, 1, 1); PG8_STAGE(PG8_SB(1, 0), b3, voffB); PG8_STAGE(PG8_SB(1, 1), b3 + hstep, voffB); PG8_STAGE(PG8_SA(1, 0), a3, voffA);
            PG8_WAIT_V(8); PG8_WAIT_L(0); PG8_BAR; PG8_MMA(1, 0, At, B0); PG8_MMA(1, 1, At, B1); PG8_BAR; PG8_SCHED;
            } else {
            PG8_LDB(B0, 0, 0); PG8_SCHED; PG8_LDA(At, 0, 0); PG8_STAGE(PG8_SA(1, 1), a1 + hstep, voffA);
            PG8_WAIT_L(8); PG8_BAR; PG8_WAIT_L(0); PG8_MMA(0, 0, At, B0); PG8_BAR; PG8_SCHED;
            PG8_LDB(B1, 0, 1); PG8_STAGE(PG8_SB(0, 0), b2, voffB);
            PG8_BAR; PG8_WAIT_L(0); PG8_MMA(0, 1, At, B1); PG8_BAR;
            PG8_LDA(At, 0, 1); PG8_STAGE(PG8_SA(0, 0), a2, voffA);
            PG8_BAR; PG8_WAIT_L(0); PG8_MMA(1, 0, At, B0); PG8_BAR; PG8_SCHED;
            PG8_STAGE(PG8_SB(0, 1), b2 + hstep, voffB);
            PG8_WAIT_V(6); PG8_BAR; PG8_MMA(1, 1, At, B1); PG8_BAR;
            PG8_LDB(B0, 1, 0); PG8_SCHED; PG8_LDA(At, 1, 0); PG8_STAGE(PG8_SA(0, 1), a2 + hstep, voffA);
            PG8_WAIT_L(8); PG8_BAR; PG8_WAIT_L(0); PG8_MMA(0, 0, At, B0); PG8_BAR; PG8_SCHED;
            PG8_LDB(B1, 1, 1); PG8_STAGE(PG8_SB(1, 0), b3, voffB);
            PG8_BAR; PG8_WAIT_L(0); PG8_MMA(0, 1, At, B1); PG8_BAR;
            PG8_LDA(At, 1, 1); PG8_STAGE(PG8_SA(1, 0), a3, voffA);
            PG8_BAR; PG8_WAIT_L(0); PG8_MMA(1, 0, At, B0); PG8_BAR; PG8_SCHED;
            PG8_STAGE(PG8_SB(1, 1), b3 + hstep, voffB);
            PG8_WAIT_V(6); PG8_BAR; PG8_MMA(1, 1, At, B1); PG8_BAR;
            }
        }
        if constexpr (ALIGN_EPI) { if (wr == 0) PG8_BAR; }
        if constexpr (!Epi::AFTER_DRAIN) { E(acc, cur, wr, wc, fr, fq); S.done(cur); }
        if (!has_next) break;
#pragma unroll
        for (int a = 0; a < 2; ++a)
#pragma unroll
            for (int b = 0; b < 2; ++b)
#pragma unroll
                for (int m = 0; m < 4; ++m)
#pragma unroll
                    for (int n = 0; n < 2; ++n) acc[a][b][m][n] = (f32x4){0.f, 0.f, 0.f, 0.f};
        cur = nxt; cA = nA; cB = nB; ++ui;
        if constexpr (ALIGN_EPI) { if (wr == 1) PG8_BAR; }
    }
    PG8_WAIT_V(0);
    if constexpr (!ALIGN_EPI) { if (wr == 0) PG8_BAR; }
    PG8_BAR;
    if constexpr (Epi::AFTER_DRAIN) { E.fused(acc, cur, wr, wc, fr, fq, lds, wid, lane); S.done(cur); }
#undef PG8_SA
#undef PG8_SB
#undef PG8_STAGE
#undef PG8_LDA
#undef PG8_LDB
#undef PG8_MMA
#undef PG8_WAIT_V
#undef PG8_WAIT_L
#undef PG8_BAR
#undef PG8_SCHED
}
}

constexpr int DM = 2048, FF = 5632, NPROMPT = 8192, NSAMP = 128, NTOK = 8320, MP = 8448, SEQ = 2048, NBATCH = 4;
constexpr int NGU = 2 * FF;
constexpr int LDP = 14848;
constexpr int NPROJ = 15104;
constexpr int PQ = 0, PK = 1024, PV = 2048, POG = 4096, PZ = 6144, PXBC = 8192, PGATE = 10752;
constexpr int XBC = 2560, IN_DIM = 14888;
constexpr float NEG_INIT = -1e30f;
constexpr size_t O_Y = 0, O_PCONV = 17039360, O_PC = 17070080, O_PN = 19167232, O_PM = 19171328, O_PSSM = 19171344,
                 O_SCONV = 20219920, O_SC = 21202960, O_SN = 88311824, O_SM = 88442896, O_SSSM = 88443408;
constexpr size_t MiB = 1u << 20;
constexpr size_t WS_SSQ = 0, WS_BAR = 1 * MiB, WS_WGU1 = 2 * MiB, WS_WD1 = 46 * MiB, WS_WIN = 68 * MiB, WS_WOUT = 127 * MiB, WS_WGU2 = 135 * MiB, WS_WD2 = 179 * MiB,
                 WS_XB = 202 * MiB, WS_MERGED = 235 * MiB, WS_X1 = 268 * MiB, WS_H = 334 * MiB, WS_PROJ = 425 * MiB, WS_GSM = 665 * MiB, WS_HML = 668 * MiB, WS_YS = 734 * MiB, WS_XA = 800 * MiB, WS_END = 844 * MiB;
constexpr int SSQ0 = 0, SSQ1 = MP, SSQ2 = 2 * MP, SSQ3 = 3 * MP, SSQA = 4 * MP, SSQB = 8 * MP, SSQ_WORDS = 10 * MP;
constexpr int LDS_BYTES = 147456;
constexpr int NWAVES = 8, NTHR = 512;

#define LAS __attribute__((address_space(3)))
typedef unsigned short bf16;
typedef float f32x4 __attribute__((ext_vector_type(4)));
typedef short bf16x8 __attribute__((ext_vector_type(8)));
typedef unsigned u32x4 __attribute__((ext_vector_type(4)));
typedef unsigned u32x2 __attribute__((ext_vector_type(2)));
typedef unsigned long long u64;
typedef float f32x2 __attribute__((ext_vector_type(2)));
using pg8::pk_bf16; using pg8::SSQ_SCALE; using pg8::rs_from; using pg8::silu_f; using pg8::sigm_f;
DI float bf2f(unsigned v) { return __uint_as_float(v << 16); }
DI bf16 f2bf(float f) { return (bf16)(pk_bf16(f, 0.f) & 0xffffu); }
DI float wave_sum(float v) {
#pragma unroll
    for (int o = 1; o < 64; o <<= 1) v += __shfl_xor(v, o);
    return v;
}
typedef short s16x4 __attribute__((ext_vector_type(4)));
DI s16x4 lds_tr4(const LAS unsigned short* p) { return __builtin_amdgcn_ds_read_tr16_b64_v4i16((LAS s16x4*)p); }
DI f32x4 mfma16(bf16x8 a, bf16x8 b, f32x4 c) { return __builtin_amdgcn_mfma_f32_16x16x32_bf16(a, b, c, 0, 0, 0); }
DI float log_sigmoid(float x) { return fminf(x, 0.f) - log1pf(__expf(-fabsf(x))); }
DI float softplus_f(float x) { return fmaxf(x, 0.f) + log1pf(__expf(-fabsf(x))); }

struct Args { const float* in[28]; float* out; unsigned char* ws; };

DI int map_in(int n) {
    if (n < 4096) return n;
    if (n < 4100) return 14848 + (n - 4096);
    if (n < 4104) return 14852 + (n - 4100);
    if (n < 6152) return POG + (n - 4104);
    if (n < 8200) return PZ + (n - 6152);
    if (n < 10760) return PXBC + (n - 8200);
    if (n < 10792) return 14856 + (n - 10760);
    return PGATE + (n - 10792);
}
struct TItem { const float* W; bf16* WT; const float* wk; int K, N, mode, k0, n0; };
DI TItem decode_item(const Args& a, int it) {
    constexpr int I_G = (DM / 64) * (FF / 64), I_D = (FF / 64) * (DM / 64), I_IN = (DM / 64) * ((IN_DIM + 63) / 64), I_O = (DM / 64) * (DM / 64);
    unsigned char* ws = a.ws; TItem d; int r = it, nblk;
    if (r < I_G) { d.W = a.in[8]; d.WT = (bf16*)(ws + WS_WGU1); d.wk = a.in[7]; d.K = DM; d.N = FF; d.mode = 1; }
    else if ((r -= I_G) < I_G) { d.W = a.in[9]; d.WT = (bf16*)(ws + WS_WGU1); d.wk = a.in[7]; d.K = DM; d.N = FF; d.mode = 2; }
    else if ((r -= I_G) < I_IN) { d.W = a.in[12]; d.WT = (bf16*)(ws + WS_WIN); d.wk = a.in[11]; d.K = DM; d.N = IN_DIM; d.mode = 3; }
    else if ((r -= I_IN) < I_D) { d.W = a.in[10]; d.WT = (bf16*)(ws + WS_WD1); d.wk = nullptr; d.K = FF; d.N = DM; d.mode = 0; }
    else if ((r -= I_D) < I_G) { d.W = a.in[24]; d.WT = (bf16*)(ws + WS_WGU2); d.wk = a.in[23]; d.K = DM; d.N = FF; d.mode = 1; }
    else if ((r -= I_G) < I_O) { d.W = a.in[22]; d.WT = (bf16*)(ws + WS_WOUT); d.wk = nullptr; d.K = DM; d.N = DM; d.mode = 0; }
    else if ((r -= I_O) < I_D) { d.W = a.in[26]; d.WT = (bf16*)(ws + WS_WD2); d.wk = nullptr; d.K = FF; d.N = DM; d.mode = 0; }
    else { r -= I_D; d.W = a.in[25]; d.WT = (bf16*)(ws + WS_WGU2); d.wk = a.in[23]; d.K = DM; d.N = FF; d.mode = 2; }
    nblk = (d.N + 63) / 64; d.k0 = 64 * (r / nblk); d.n0 = 64 * (r % nblk);
    return d;
}
DI void titem_load(const TItem& d, f32x4 (&v)[16], float (&kw)[16], int lane) {
    const int n = d.n0 + 4 * (lane & 15), kq = lane >> 4; const bool ok = n < d.N;
#pragma unroll
    for (int i = 0; i < 16; ++i) { v[i] = (f32x4){0.f, 0.f, 0.f, 0.f}; if (ok) v[i] = __builtin_nontemporal_load((const f32x4*)(d.W + (size_t)(d.k0 + 4 * i + kq) * d.N + n)); }
#pragma unroll
    for (int i = 0; i < 16; ++i) kw[i] = d.wk ? d.wk[d.k0 + 4 * i + kq] : 1.f;
}
DI void titem_store(const TItem& d, const f32x4 (&v)[16], const float (&kw)[16], LAS float* scr, int lane) {
    const int kq = lane >> 4, nl4 = 4 * (lane & 15);
#pragma unroll
    for (int i = 0; i < 16; ++i) { LAS float* p = scr + (4 * i + kq) * 65 + nl4; const f32x4 x = v[i] * kw[i]; p[0] = x[0]; p[1] = x[1]; p[2] = x[2]; p[3] = x[3]; }
    asm volatile("s_waitcnt lgkmcnt(0)" ::: "memory");
    const int c = lane & 7;
#pragma unroll
    for (int j = 0; j < 8; ++j) { const int nl = (lane >> 3) + 8 * j, n = d.n0 + nl; const LAS float* s = scr + (8 * c) * 65 + nl;
        if (n < d.N) {
            int dst; float sc = 1.f;
            if (d.mode == 0) dst = n; else if (d.mode == 1) dst = (n >> 7) * 256 + (n & 127); else if (d.mode == 2) dst = (n >> 7) * 256 + 128 + (n & 127); else { dst = map_in(n); if (n < 1024) sc = 0.0625f; }
            u32x4 o; o.x = pk_bf16(s[0 * 65] * sc, s[1 * 65] * sc); o.y = pk_bf16(s[2 * 65] * sc, s[3 * 65] * sc); o.z = pk_bf16(s[4 * 65] * sc, s[5 * 65] * sc); o.w = pk_bf16(s[6 * 65] * sc, s[7 * 65] * sc);
            *(u32x4*)(d.WT + (size_t)dst * d.K + d.k0 + 8 * c) = o; } }
    asm volatile("s_waitcnt lgkmcnt(0)" ::: "memory");
}
constexpr int CV_I_G = (DM / 64) * (FF / 64), CV_I_D = (FF / 64) * (DM / 64), CV_I_IN = (DM / 64) * ((IN_DIM + 63) / 64), CV_I_O = (DM / 64) * (DM / 64);
constexpr int CV_PROLOGUE_END = 2 * CV_I_G + CV_I_IN, CV_G1TAIL_END = CV_PROLOGUE_END + CV_I_D + CV_I_G, CV_END = CV_G1TAIL_END + CV_I_O + CV_I_D + CV_I_G;
DI void convert_items(LAS unsigned char* lds, const Args& a, int first, int last, int widx, int nworkers) {
    int tid_ = threadIdx.x; asm volatile("" : "+v"(tid_)); const int tid = tid_, lane = tid & 63, wave = __builtin_amdgcn_readfirstlane(tid >> 6);
    LAS float* scr = (LAS float*)(lds + wave * 16640);
    int it = first + widx;
    if (it < last) {
        TItem d = decode_item(a, it); f32x4 cur[16]; float ckw[16];
        titem_load(d, cur, ckw, lane);
        for (;;) {
            const int itn = it + nworkers; const bool more = itn < last;
            TItem dn = d; f32x4 nxt[16]; float nkw[16];
            if (more) { dn = decode_item(a, itn); titem_load(dn, nxt, nkw, lane); }
            titem_store(d, cur, ckw, scr, lane);
            if (!more) break;
#pragma unroll
            for (int i = 0; i < 16; ++i) { cur[i] = nxt[i]; ckw[i] = nkw[i]; }
            d = dn; it = itn;
        }
    }
}
DI void p0_prologue(LAS unsigned char* lds, const Args& a, int vcu, int G) {
    int tid_ = threadIdx.x; asm volatile("" : "+v"(tid_)); const int tid = tid_, lane = tid & 63, wave = __builtin_amdgcn_readfirstlane(tid >> 6);
    unsigned char* ws = a.ws;
    LAS float* scr = (LAS float*)(lds + wave * 16640);
    const int gw = vcu * NWAVES + wave, NGW = G * NWAVES;
    { u64* q = (u64*)(ws + WS_SSQ); for (int i = (int)(blockIdx.x * NTHR + tid); i < SSQ_WORDS - MP; i += G * NTHR) q[MP + i] = 0ull; }
    constexpr int I_G = (DM / 64) * (FF / 64), I_D = (FF / 64) * (DM / 64), I_IN = (DM / 64) * ((IN_DIM + 63) / 64), I_O = (DM / 64) * (DM / 64);
    constexpr int NITEMS = 4 * I_G + 2 * I_D + I_IN + I_O;
    bf16* xb = (bf16*)(ws + WS_XB); u64* ssq0 = (u64*)(ws + WS_SSQ) + SSQ0;
    for (int m = gw; m < NTOK; m += NGW) {
        const float* xr = m < NPROMPT ? a.in[0] + (size_t)m * DM : a.in[1] + (size_t)(m - NPROMPT) * DM;
        f32x4 v[8];
#pragma unroll
        for (int j = 0; j < 8; ++j) v[j] = *(const f32x4*)(xr + 4 * lane + 256 * j);
        float ss = 0.f;
#pragma unroll
        for (int j = 0; j < 8; ++j) { ss += (v[j][0] * v[j][0] + v[j][1] * v[j][1]) + (v[j][2] * v[j][2] + v[j][3] * v[j][3]);
            u32x2 w; w.x = pk_bf16(v[j][0], v[j][1]); w.y = pk_bf16(v[j][2], v[j][3]); *(u32x2*)(xb + (size_t)m * DM + 4 * lane + 256 * j) = w; }
        ss = wave_sum(ss);
        if (lane == 0) ssq0[m] = (u64)(ss * SSQ_SCALE);
    }
    convert_items(lds, a, 0, CV_PROLOGUE_END, gw, NGW);
}

DI void conv_pass(const Args& a, int vcu, int G) {
    int tid_ = threadIdx.x; asm volatile("" : "+v"(tid_)); const int tid = tid_;
    const bf16* proj = (const bf16*)(a.ws + WS_PROJ); bf16* XA = (bf16*)(a.ws + WS_XA);
    const float* cwt = a.in[16]; const float* cbs = a.in[17]; const float* stc = a.in[2];
    const int gt = vcu * NTHR + tid, NGT = G * NTHR;
    constexpr int NCG = XBC / 8, RUN = 16, NRUN = NPROMPT / RUN;
    for (int item = gt; item < NRUN * NCG + NSAMP * NCG; item += NGT) {
        const bool samp = item >= NRUN * NCG; const int it2 = samp ? item - NRUN * NCG : item;
        const int cg8 = it2 % NCG, run = it2 / NCG, ch = 8 * cg8;
        float wv[4][8], bs[8];
#pragma unroll
        for (int jj = 0; jj < 4; ++jj) { const f32x4 w0 = *(const f32x4*)(cwt + jj * XBC + ch), w1 = *(const f32x4*)(cwt + jj * XBC + ch + 4);
#pragma unroll
            for (int e = 0; e < 4; ++e) { wv[jj][e] = w0[e]; wv[jj][4 + e] = w1[e]; } }
        { const f32x4 b0 = *(const f32x4*)(cbs + ch), b1 = *(const f32x4*)(cbs + ch + 4);
#pragma unroll
          for (int e = 0; e < 4; ++e) { bs[e] = b0[e]; bs[4 + e] = b1[e]; } }
        if (!samp) {
            const int b = run / (SEQ / RUN), t0 = (run % (SEQ / RUN)) * RUN;
            const bf16* base = proj + ((size_t)b * SEQ) * LDP + PXBC + ch;
            u32x4 rw[RUN + 3];
#pragma unroll
            for (int r = 0; r < RUN + 3; ++r) { const int tt = t0 - 3 + r; rw[r] = (u32x4){0u, 0u, 0u, 0u}; if (tt >= 0) rw[r] = *(const u32x4*)(base + (size_t)tt * LDP); }
#pragma unroll
            for (int r = 0; r < RUN; ++r) { float o[8];
#pragma unroll
                for (int e = 0; e < 8; ++e) { float acc = bs[e];
#pragma unroll
                    for (int jj = 0; jj < 4; ++jj) { const unsigned word = rw[r + jj][e >> 1]; acc += wv[jj][e] * ((e & 1) ? __uint_as_float(word & 0xffff0000u) : __uint_as_float(word << 16)); }
                    o[e] = silu_f(acc); }
                u32x4 ov; ov.x = pk_bf16(o[0], o[1]); ov.y = pk_bf16(o[2], o[3]); ov.z = pk_bf16(o[4], o[5]); ov.w = pk_bf16(o[6], o[7]);
                *(u32x4*)(XA + ((size_t)b * SEQ + t0 + r) * XBC + ch) = ov; }
        } else {
            const int bs_i = run; const float* st = stc + (size_t)bs_i * 3 * XBC + ch; const u32x4 nw = *(const u32x4*)(proj + ((size_t)NPROMPT + bs_i) * LDP + PXBC + ch);
            float o[8];
#pragma unroll
            for (int e = 0; e < 8; ++e) { const unsigned word = nw[e >> 1]; const float xv = (e & 1) ? __uint_as_float(word & 0xffff0000u) : __uint_as_float(word << 16);
                o[e] = silu_f(bs[e] + wv[0][e] * st[e] + wv[1][e] * st[XBC + e] + wv[2][e] * st[2 * XBC + e] + wv[3][e] * xv); }
            u32x4 ov; ov.x = pk_bf16(o[0], o[1]); ov.y = pk_bf16(o[2], o[3]); ov.z = pk_bf16(o[4], o[5]); ov.w = pk_bf16(o[6], o[7]);
            *(u32x4*)(XA + ((size_t)NPROMPT + bs_i) * XBC + ch) = ov;
        }
    }
}

constexpr int ML_CT = 0, ML_KS = 34320, ML_VT = 101904, ML_VTW = 119584, ML_SB = 137264, ML_SBN = 516;
DI float mlstm_scan(float ig0, float ig1, float fg0, float fg1, float ib, float fb, int lane, LAS float* sb, float mst) {
    const float li0 = ig0 + ib, li1 = ig1 + ib, lf0 = log_sigmoid(fg0 + fb), lf1 = log_sigmoid(fg1 + fb);
    float s = lf0 + lf1;
#pragma unroll
    for (int o = 1; o < 64; o <<= 1) { const float tv = __shfl_up(s, o); if (lane >= o) s += tv; }
    const float b1 = s, b0 = s - lf1, g0 = li0 - b0, g1 = li1 - b1;
    float pmx = fmaxf(g0, g1);
#pragma unroll
    for (int o = 1; o < 64; o <<= 1) { const float tv = __shfl_up(pmx, o); if (lane >= o) pmx = fmaxf(pmx, tv); }
    float prev = __shfl_up(pmx, 1); if (lane == 0) prev = -INFINITY;
    const float M0 = fmaxf(mst, fmaxf(prev, g0)), M1 = fmaxf(mst, pmx);
    const float M127 = __shfl(M1, 63), b127 = __shfl(b1, 63);
    *(LAS f32x2*)(sb + 2 * lane) = (f32x2){g0, g1}; *(LAS f32x2*)(sb + 128 + 2 * lane) = (f32x2){b0, b1}; *(LAS f32x2*)(sb + 256 + 2 * lane) = (f32x2){M0, M1};
    *(LAS f32x2*)(sb + 384 + 2 * lane) = (f32x2){__expf(g0 - M127), __expf(g1 - M127)};
    if (lane == 0) { sb[512] = __expf(mst - M127); sb[513] = b127 + M127; sb[514] = mst; }
    return b127 + M127;
}
DI void mlstm_prompt_unit(LAS unsigned char* lds, int unit, const bf16* proj, const float* gsm, const float* i_bias, const float* f_bias,
                          bf16* hml, u64* ssqA, float* pC, float* pn, float* pm, bool atom) {
    int tid_ = threadIdx.x; asm volatile("" : "+v"(tid_)); const int tid = tid_, lane = tid & 63, w = __builtin_amdgcn_readfirstlane(tid >> 6), fr = lane & 15, fq = lane >> 4;
    const int bh = unit >> 3, j = unit & 7, b = bh >> 2, h = bh & 3;
    LAS bf16* CT = (LAS bf16*)(lds + ML_CT); LAS bf16* Ks = (LAS bf16*)(lds + ML_KS); LAS bf16* Vt = (LAS bf16*)(lds + ML_VT); LAS bf16* Vtw = (LAS bf16*)(lds + ML_VTW);
    LAS float* sbuf = (LAS float*)(lds + ML_SB);
    for (int i = tid; i < 65 * 264 / 2; i += NTHR) ((LAS unsigned*)CT)[i] = 0u;
    if (tid < 136) Vt[64 * 136 + tid] = (bf16)0x3F80u;
    f32x4 Cacc[2][5];
#pragma unroll
    for (int e = 0; e < 2; ++e)
#pragma unroll
        for (int d = 0; d < 5; ++d) Cacc[e][d] = (f32x4){0.f, 0.f, 0.f, 0.f};
    const float ib = i_bias[h], fb = f_bias[h];
    const size_t tokb = (size_t)b * SEQ;
    u32x4 kreg[8], vreg[2]; bf16x8 qnx[8]; float mrun = NEG_INIT;
    const unsigned koff = (unsigned)((tid >> 5) * (LDP * 2) + (tid & 31) * 16), voff = (unsigned)((tid >> 2) * (LDP * 2) + (tid & 3) * 32);
    const unsigned qoff = (unsigned)((16 * w + fr) * (LDP * 2) + fq * 16), goff = (unsigned)lane * 512u, hoff = (unsigned)((16 * w + fr) * (DM * 2) + fq * 8);
    const char* pk0 = (const char*)(proj + tokb * LDP + PK + h * 256); const char* pv0 = (const char*)(proj + tokb * LDP + PV + h * 512 + 64 * j);
    const char* pq0 = (const char*)(proj + tokb * LDP + PQ + h * 256); const char* pg0 = (const char*)(gsm + tokb * 64 + h); char* ph0 = (char*)(hml + tokb * DM + h * 512 + 64 * j);
#define ML_LOAD_KV(c_) do { const size_t cb_ = (size_t)(c_) * 128 * LDP * 2; \
        _Pragma("unroll") for (int i = 0; i < 8; ++i) kreg[i] = *(const u32x4*)(pk0 + cb_ + (size_t)i * 16 * LDP * 2 + koff); \
        _Pragma("unroll") for (int i = 0; i < 2; ++i) vreg[i] = *(const u32x4*)(pv0 + cb_ + 16 * i + voff); \
        _Pragma("unroll") for (int kk = 0; kk < 8; ++kk) qnx[kk] = *(const bf16x8*)(pq0 + cb_ + 64 * kk + qoff); \
        } while (0)
#define ML_LOAD_G(c_) do { { const char* gp_ = pg0 + (size_t)(c_) * 128 * 256 + goff; gz[0] = *(const float*)gp_; gz[1] = *(const float*)(gp_ + 256); gz[2] = *(const float*)(gp_ + 16); gz[3] = *(const float*)(gp_ + 256 + 16); } } while (0)
    ML_LOAD_KV(0);
    if (w == 0) { float gz[4]; ML_LOAD_G(0); mrun = mlstm_scan(gz[0], gz[1], gz[2], gz[3], ib, fb, lane, sbuf, mrun); }
    __syncthreads();
#define LAUNDER(p) asm volatile("" : "+v"(p))
    for (int c = 0; c < 16; ++c) {
        const size_t tok0 = tokb + (size_t)c * 128;
        LAS float* sc = sbuf + (c & 1) * ML_SBN; LAS float* sn = sbuf + ((c + 1) & 1) * ML_SBN;
        const int t = 16 * w + fr;
        LAS bf16* ksw = Ks + (tid >> 5) * 264 + 8 * (tid & 31); LAS bf16* vtw_ = Vt + (16 * (tid & 3)) * 136 + (tid >> 2);
        const LAS bf16* ksr = Ks + fr * 264 + 8 * fq; const LAS bf16* ctr = CT + fr * 264 + 8 * fq; const LAS bf16* vtr = Vt + fr * 136 + 4 * fq; const LAS bf16* vtwr = Vtw + fr * 136 + 8 * fq;
        const LAS bf16* kgr = Ks + (8 * fq + (fr >> 2)) * 264 + 32 * w + 4 * (fr & 3); LAS bf16* ctw = CT + (4 * fq) * 264 + 32 * w + fr;
        const LAS float* scq = sc + 4 * fq; const LAS float* sct = sc + t; const LAS float* scs = sc + (tid >> 2);
        LAUNDER(ksw); LAUNDER(vtw_); LAS bf16* vtww = vtw_ + (ML_VTW - ML_VT) / 2; LAUNDER(ksr); LAUNDER(ctr); LAUNDER(vtr); LAUNDER(vtwr); LAUNDER(kgr); LAUNDER(ctw); LAUNDER(scq); LAUNDER(sct); LAUNDER(scs);
        bf16x8 qf[8];
#pragma unroll
        for (int kk = 0; kk < 8; ++kk) qf[kk] = qnx[kk];
#pragma unroll
        for (int i = 0; i < 8; ++i) *(LAS u32x4*)(ksw + i * 16 * 264) = kreg[i];
        {   const float we = scs[384];
#pragma unroll
            for (int e = 0; e < 16; ++e) { const unsigned word = vreg[e >> 3][(e >> 1) & 3]; const unsigned raw = (e & 1) ? (word >> 16) : (word & 0xffffu);
                vtw_[e * 136] = (bf16)raw; vtww[e * 136] = f2bf(bf2f(raw) * we); }
            if (tid < 128) Vtw[64 * 136 + tid] = f2bf(sc[384 + tid]); }
        __syncthreads();
        {
            const float Mt = sct[256], mold = sc[514];
            bf16x8 af[4];
#pragma unroll
            for (int p = 0; p < 4; ++p) { u32x4 pw;
#pragma unroll
                for (int hf = 0; hf < 2; ++hf) { const int sb = 2 * p + hf; f32x4 sa = (f32x4){0.f, 0.f, 0.f, 0.f};
                    if (sb <= w) {
#pragma unroll
                        for (int kk = 0; kk < 8; ++kk) { const bf16x8 kf = *(const LAS bf16x8*)(ksr + (16 * sb) * 264 + 32 * kk); sa = mfma16(kf, qf[kk], sa); } }
                    float v[4]; const f32x4 g4v = *(const LAS f32x4*)(scq + 16 * sb);
#pragma unroll
                    for (int i = 0; i < 4; ++i) { const int s = 16 * sb + 4 * fq + i; v[i] = (sb <= w && s <= t) ? sa[i] * __expf(g4v[i] - Mt) : 0.f; }
                    pw[2 * hf] = pk_bf16(v[0], v[1]); pw[2 * hf + 1] = pk_bf16(v[2], v[3]); }
                af[p] = __builtin_bit_cast(bf16x8, pw);
                __builtin_amdgcn_sched_barrier(0); }
#define ML_NACC(db, dst) do { dst = (f32x4){0.f, 0.f, 0.f, 0.f}; _Pragma("unroll") for (int p = 0; p < 4; ++p) if (2 * p <= w) { const LAS bf16* vp = vtr + (16 * (db)) * 136 + 32 * p; \
                const u32x2 lo = *(const LAS u32x2*)vp, hi = *(const LAS u32x2*)(vp + 16); u32x4 vv; vv.x = lo.x; vv.y = lo.y; vv.z = hi.x; vv.w = hi.y; dst = mfma16(__builtin_bit_cast(bf16x8, vv), af[p], dst); } } while (0)
#define ML_CACC(db, dst) do { dst = (f32x4){0.f, 0.f, 0.f, 0.f}; _Pragma("unroll") for (int kk = 0; kk < 8; ++kk) { const bf16x8 cf = *(const LAS bf16x8*)(ctr + (16 * (db)) * 264 + 32 * kk); dst = mfma16(cf, qf[kk], dst); } } while (0)
            f32x4 n4, c4; ML_NACC(4, n4); ML_CACC(4, c4);
            const float rowsum = __shfl(n4[0], fr), qn = __shfl(c4[0], fr);
            const float winter = __expf(mold - Mt), den = rowsum + winter * qn, mt = sct[128] + Mt;
            const float inv = 1.0f / fmaxf(fabsf(den), __expf(-mt));
            float ss = 0.f;
#pragma unroll
            for (int db = 0; db < 4; ++db) { f32x4 na, ca; ML_NACC(db, na); ML_CACC(db, ca);
                const f32x4 hv = (na + ca * winter) * inv; ss += (hv[0] * hv[0] + hv[1] * hv[1]) + (hv[2] * hv[2] + hv[3] * hv[3]);
                { u32x2 hw_; hw_.x = pk_bf16(hv[0], hv[1]); hw_.y = pk_bf16(hv[2], hv[3]); *(u32x2*)(ph0 + (size_t)c * 128 * DM * 2 + 32 * db + hoff) = hw_; } }
#undef ML_NACC
#undef ML_CACC
            ss += __shfl_xor(ss, 16); ss += __shfl_xor(ss, 32);
            if (fq == 0 && atom) atomicAdd(ssqA + (tok0 + t) * 4 + h, (u64)(ss * SSQ_SCALE));
        }
        if (w == 0 && c < 15) { float gz[4]; ML_LOAD_G(c + 1); mrun = mlstm_scan(gz[0], gz[1], gz[2], gz[3], ib, fb, lane, sn, mrun); }
        __syncthreads();
        {
            if (c < 15) ML_LOAD_KV(c + 1);
            const float decay = sc[512];
#pragma unroll
            for (int e = 0; e < 2; ++e)
#pragma unroll
                for (int d = 0; d < 5; ++d) Cacc[e][d] = Cacc[e][d] * decay;
#pragma unroll
            for (int p = 0; p < 4; ++p) { bf16x8 vtw[5];
#pragma unroll
                for (int db = 0; db < 5; ++db) vtw[db] = *(const LAS bf16x8*)(vtwr + (16 * db) * 136 + 32 * p);
#pragma unroll
                for (int eb = 0; eb < 2; ++eb) { const s16x4 k0 = lds_tr4(kgr + (32 * p) * 264 + 16 * eb), k1 = lds_tr4(kgr + (32 * p + 4) * 264 + 16 * eb);
                    const bf16x8 kt = (bf16x8){k0[0], k0[1], k0[2], k0[3], k1[0], k1[1], k1[2], k1[3]};
#pragma unroll
                    for (int db = 0; db < 5; ++db) Cacc[eb][db] = mfma16(vtw[db], kt, Cacc[eb][db]); } }
#pragma unroll
            for (int eb = 0; eb < 2; ++eb) {
#pragma unroll
                for (int db = 0; db < 4; ++db)
#pragma unroll
                    for (int i = 0; i < 4; ++i) ctw[(16 * db + i) * 264 + 16 * eb] = f2bf(Cacc[eb][db][i]);
                if (fq == 0) ctw[64 * 264 + 16 * eb] = f2bf(Cacc[eb][4][0]); }
        }
        __syncthreads();
    }
#undef ML_LOAD_KV
#undef ML_LOAD_G
#pragma unroll
    for (int eb = 0; eb < 2; ++eb) {
#pragma unroll
        for (int db = 0; db < 4; ++db) *(f32x4*)(pC + ((size_t)bh * 256 + 32 * w + 16 * eb + fr) * 512 + 64 * j + 16 * db + 4 * fq) = Cacc[eb][db];
        if (j == 0 && fq == 0) pn[bh * 256 + 32 * w + 16 * eb + fr] = Cacc[eb][4][0]; }
    if (j == 0 && tid == 0) pm[bh] = sbuf[ML_SBN + 513];
    __syncthreads();
}

constexpr int SD_BS = 0, SD_CS = 34816, SD_XT = 69632, SD_XTW = 87040, SD_SB = 104448, SD_SC = 121856, SD_SCN = 388;
DI void ssd_scan(float r0, float r1, float dtb, float Aneg, int lane, LAS float* sb) {
    const float dt0 = softplus_f(r0 + dtb), dt1 = softplus_f(r1 + dtb), a0 = dt0 * Aneg, a1 = dt1 * Aneg;
    float s = a0 + a1;
#pragma unroll
    for (int o = 1; o < 64; o <<= 1) { const float tv = __shfl_up(s, o); if (lane >= o) s += tv; }
    const float b1 = s, b0 = s - a1, bl = __shfl(b1, 63);
    *(LAS f32x2*)(sb + 2 * lane) = (f32x2){b0, b1}; *(LAS f32x2*)(sb + 128 + 2 * lane) = (f32x2){dt0, dt1};
    *(LAS f32x2*)(sb + 256 + 2 * lane) = (f32x2){__expf(bl - b0) * dt0, __expf(bl - b1) * dt1};
    if (lane == 0) sb[384] = __expf(bl);
}
DI void ssd_prompt_unit(LAS unsigned char* lds, int unit, const bf16* proj, const bf16* XA, const float* gsm, const float* dt_bias, const float* A_log, const float* Dsk,
                        bf16* ys, u64* ssqB, float* pS, bool atom) {
    int tid_ = threadIdx.x; asm volatile("" : "+v"(tid_)); const int tid = tid_, lane = tid & 63, w = __builtin_amdgcn_readfirstlane(tid >> 6), fr = lane & 15, fq = lane >> 4;
    const int b = unit >> 5, head = unit & 31, g = head >> 4;
    LAS bf16* Bs = (LAS bf16*)(lds + SD_BS); LAS bf16* Cs = (LAS bf16*)(lds + SD_CS); LAS bf16* Xt = (LAS bf16*)(lds + SD_XT); LAS bf16* Xtw = (LAS bf16*)(lds + SD_XTW); LAS bf16* Sb = (LAS bf16*)(lds + SD_SB);
    LAS float* sbuf = (LAS float*)(lds + SD_SC);
    for (int i = tid; i < 64 * 136 / 2; i += NTHR) ((LAS unsigned*)Sb)[i] = 0u;
    f32x4 Sacc[4];
#pragma unroll
    for (int pb = 0; pb < 4; ++pb) Sacc[pb] = (f32x4){0.f, 0.f, 0.f, 0.f};
    const float dtb = dt_bias[head], Aneg = -__expf(A_log[head]), Dk = Dsk[head];
    const size_t tokb = (size_t)b * SEQ;
    u32x4 breg[4], creg[4], xreg[2];
    const unsigned boff = (unsigned)((tid >> 4) * (XBC * 2) + (tid & 15) * 16), xoff = (unsigned)((tid >> 3) * (XBC * 2) + (tid & 7) * 16);
    const unsigned zoff = (unsigned)((16 * w + fr) * (LDP * 2) + fq * 8), goff = (unsigned)lane * 512u, yoff = (unsigned)((16 * w + fr) * (DM * 2) + fq * 8);
    const char* pb0 = (const char*)(XA + tokb * XBC + 2048 + g * 128); const char* px0 = (const char*)(XA + tokb * XBC + head * 64);
    const char* pz0 = (const char*)(proj + tokb * LDP + PZ + head * 64); const char* pg0 = (const char*)(gsm + tokb * 64 + 8 + head); char* py0 = (char*)(ys + tokb * DM + head * 64);
#define SD_LOAD(c_) do { const size_t cb_ = (size_t)(c_) * 128 * XBC * 2; \
        _Pragma("unroll") for (int i = 0; i < 4; ++i) { const char* rp_ = pb0 + cb_ + (size_t)i * 32 * XBC * 2 + boff; breg[i] = *(const u32x4*)rp_; creg[i] = *(const u32x4*)(rp_ + 512); } \
        _Pragma("unroll") for (int i = 0; i < 2; ++i) xreg[i] = *(const u32x4*)(px0 + cb_ + (size_t)i * 64 * XBC * 2 + xoff); \
        } while (0)
#define SD_LOAD_G(c_) do { const char* gp_ = pg0 + (size_t)(c_) * 128 * 256 + goff; gz[0] = *(const float*)gp_; gz[1] = *(const float*)(gp_ + 256); } while (0)
    SD_LOAD(0);
    if (w == 0) { float gz[2]; SD_LOAD_G(0); ssd_scan(gz[0], gz[1], dtb, Aneg, lane, sbuf); }
    __syncthreads();
    for (int c = 0; c < 16; ++c) {
        const size_t tok0 = tokb + (size_t)c * 128;
        LAS float* sc = sbuf + (c & 1) * SD_SCN; LAS float* sn = sbuf + ((c + 1) & 1) * SD_SCN;
        const int t = 16 * w + fr;
        LAS bf16* bsw = Bs + (tid >> 4) * 136 + 8 * (tid & 15); LAS bf16* xtw_ = Xt + (8 * (tid & 7)) * 136 + (tid >> 3);
        const LAS bf16* csr = Cs + t * 136 + 8 * fq; const LAS bf16* bsr = Bs + fr * 136 + 8 * fq; const LAS bf16* xtr = Xt + fr * 136 + 4 * fq; const LAS bf16* sbr = Sb + fr * 136 + 8 * fq;
        const LAS bf16* xtx = Xt + (4 * fq) * 136 + t; const LAS bf16* bgr = Bs + (8 * fq + (fr >> 2)) * 136 + 16 * w + 4 * (fr & 3); const LAS bf16* xtwr = Xtw + fr * 136 + 8 * fq; LAS bf16* sbw = Sb + fr * 136 + 16 * w + 4 * fq;
        const LAS float* scq = sc + 4 * fq; const LAS float* sct = sc + t; const LAS float* scs = sc + (tid >> 3);
        LAUNDER(bsw); LAUNDER(xtw_); LAUNDER(csr); LAUNDER(bsr); LAUNDER(xtr); LAUNDER(sbr); LAUNDER(xtx); LAUNDER(bgr); LAUNDER(xtwr); LAUNDER(sbw); LAUNDER(scq); LAUNDER(sct); LAUNDER(scs);
#pragma unroll
        for (int i = 0; i < 4; ++i) { *(LAS u32x4*)(bsw + i * 32 * 136) = breg[i]; *(LAS u32x4*)(bsw + (SD_CS - SD_BS) / 2 + i * 32 * 136) = creg[i]; }
#pragma unroll
        for (int i = 0; i < 2; ++i) { const float we = scs[256 + 64 * i];
#pragma unroll
            for (int e = 0; e < 8; ++e) { const unsigned word = xreg[i][e >> 1]; const unsigned raw = (e & 1) ? (word >> 16) : (word & 0xffffu);
                xtw_[e * 136 + 64 * i] = (bf16)raw; xtw_[(SD_XTW - SD_XT) / 2 + e * 136 + 64 * i] = f2bf(bf2f(raw) * we); } }
        const char* zp_ = pz0 + (size_t)c * 128 * LDP * 2 + zoff;
        const u32x2 zr0 = *(const u32x2*)zp_, zr1 = *(const u32x2*)(zp_ + 32), zr2 = *(const u32x2*)(zp_ + 64), zr3 = *(const u32x2*)(zp_ + 96);
        __syncthreads();
        {
            const float bt = sct[0];
            bf16x8 cf[4];
#pragma unroll
            for (int kk = 0; kk < 4; ++kk) cf[kk] = *(const LAS bf16x8*)(csr + 32 * kk);
            bf16x8 af[4];
#pragma unroll
            for (int p = 0; p < 4; ++p) { u32x4 pw;
#pragma unroll
                for (int hf = 0; hf < 2; ++hf) { const int sb = 2 * p + hf; f32x4 sa = (f32x4){0.f, 0.f, 0.f, 0.f};
                    if (sb <= w) {
#pragma unroll
                        for (int kk = 0; kk < 4; ++kk) { const bf16x8 bfg = *(const LAS bf16x8*)(bsr + (16 * sb) * 136 + 32 * kk); sa = mfma16(bfg, cf[kk], sa); } }
                    float v[4]; const f32x4 b4 = *(const LAS f32x4*)(scq + 16 * sb), d4 = *(const LAS f32x4*)(scq + 128 + 16 * sb);
#pragma unroll
                    for (int i = 0; i < 4; ++i) { const int s = 16 * sb + 4 * fq + i; v[i] = (sb <= w && s <= t) ? sa[i] * __expf(bt - b4[i]) * d4[i] : 0.f; }
                    pw[2 * hf] = pk_bf16(v[0], v[1]); pw[2 * hf + 1] = pk_bf16(v[2], v[3]); }
                af[p] = __builtin_bit_cast(bf16x8, pw); }
            const float ebt = __expf(bt);
            float ss = 0.f;
#pragma unroll
            for (int pb = 0; pb < 4; ++pb) { f32x4 yacc = (f32x4){0.f, 0.f, 0.f, 0.f}, y2 = yacc;
#pragma unroll
                for (int p = 0; p < 4; ++p) if (2 * p <= w) { const LAS bf16* xp = xtr + (16 * pb) * 136 + 32 * p;
                    const u32x2 lo = *(const LAS u32x2*)xp, hi = *(const LAS u32x2*)(xp + 16); u32x4 vv; vv.x = lo.x; vv.y = lo.y; vv.z = hi.x; vv.w = hi.y;
                    yacc = mfma16(__builtin_bit_cast(bf16x8, vv), af[p], yacc); }
#pragma unroll
                for (int kk = 0; kk < 4; ++kk) { const bf16x8 sf = *(const LAS bf16x8*)(sbr + (16 * pb) * 136 + 32 * kk); y2 = mfma16(sf, cf[kk], y2); }
                const u32x2 zr = pb == 0 ? zr0 : (pb == 1 ? zr1 : (pb == 2 ? zr2 : zr3));
                f32x4 o;
#pragma unroll
                for (int i = 0; i < 4; ++i) { const float xv = bf2f(xtx[(16 * pb + i) * 136]); const unsigned zw = zr[i >> 1]; const float z = (i & 1) ? __uint_as_float(zw & 0xffff0000u) : __uint_as_float(zw << 16);
                    const float y = yacc[i] + ebt * y2[i] + Dk * xv; o[i] = y * silu_f(z); ss += o[i] * o[i]; }
                { u32x2 ow_; ow_.x = pk_bf16(o[0], o[1]); ow_.y = pk_bf16(o[2], o[3]); *(u32x2*)(py0 + (size_t)c * 128 * DM * 2 + 32 * pb + yoff) = ow_; } }
            ss += __shfl_xor(ss, 16); ss += __shfl_xor(ss, 32);
            if (fq == 0 && atom) atomicAdd(ssqB + (tok0 + t) * 2 + g, (u64)(ss * SSQ_SCALE));
        }
        if (w == 0 && c < 15) { float gz[2]; SD_LOAD_G(c + 1); ssd_scan(gz[0], gz[1], dtb, Aneg, lane, sn); }
        __syncthreads();
        {
            if (c < 15) SD_LOAD(c + 1);
            const float eb = sc[384];
#pragma unroll
            for (int pb = 0; pb < 4; ++pb) Sacc[pb] = Sacc[pb] * eb;
#pragma unroll
            for (int p = 0; p < 4; ++p) { const s16x4 b0 = lds_tr4(bgr + (32 * p) * 136), b1 = lds_tr4(bgr + (32 * p + 4) * 136);
                const bf16x8 btf = (bf16x8){b0[0], b0[1], b0[2], b0[3], b1[0], b1[1], b1[2], b1[3]};
#pragma unroll
                for (int pb = 0; pb < 4; ++pb) { const bf16x8 xf = *(const LAS bf16x8*)(xtwr + (16 * pb) * 136 + 32 * p); Sacc[pb] = mfma16(btf, xf, Sacc[pb]); } }
#pragma unroll
            for (int pb = 0; pb < 4; ++pb) { u32x2 o; o.x = pk_bf16(Sacc[pb][0], Sacc[pb][1]); o.y = pk_bf16(Sacc[pb][2], Sacc[pb][3]); *(LAS u32x2*)(sbw + (16 * pb) * 136) = o; }
        }
        __syncthreads();
    }
#undef SD_LOAD
#undef SD_LOAD_G
#pragma unroll
    for (int pb = 0; pb < 4; ++pb) *(f32x4*)(pS + (((size_t)b * 32 + head) * 64 + 16 * pb + fr) * 128 + 16 * w + 4 * fq) = Sacc[pb];
    __syncthreads();
}

DI void mlstm_decode_unit(LAS unsigned char* lds, int unit, const bf16* proj, const float* gsm, const float* i_bias, const float* f_bias,
                          const float* stC, const float* stn, const float* stm, bf16* hml, u64* ssqA, float* sC, float* sn, float* sm, bool atom) {
    int tid_ = threadIdx.x; asm volatile("" : "+v"(tid_)); const int tid = tid_, lane = tid & 63, w = __builtin_amdgcn_readfirstlane(tid >> 6);
    const int bs = unit >> 2, h = unit & 3; const size_t R = (size_t)NPROMPT + bs;
    LAS float* qs = (LAS float*)lds; LAS float* ks = qs + 256; LAS float* vs = ks + 256; LAS float* ns = vs + 512; LAS float* red = ns + 256; LAS f32x4* red4 = (LAS f32x4*)(red + 64);
    if (tid < 256) { qs[tid] = bf2f(proj[R * LDP + PQ + h * 256 + tid]); ks[tid] = bf2f(proj[R * LDP + PK + h * 256 + tid]); ns[tid] = stn[(size_t)unit * 256 + tid]; }
    vs[tid] = bf2f(proj[R * LDP + PV + h * 512 + tid]);
    __syncthreads();
    { float pqk = 0.f, pqn = 0.f; if (tid < 256) { pqk = qs[tid] * ks[tid]; pqn = qs[tid] * ns[tid]; }
      pqk = wave_sum(pqk); pqn = wave_sum(pqn); if (lane == 0) { red[w] = pqk; red[8 + w] = pqn; } }
    __syncthreads();
    const float qk = (red[0] + red[1]) + (red[2] + red[3]), qn = (red[8] + red[9]) + (red[10] + red[11]);
    const float li = gsm[R * 64 + h] + i_bias[h], lf = log_sigmoid(gsm[R * 64 + 4 + h] + f_bias[h]), m0 = stm[unit];
    const float mt = fmaxf(lf + m0, li), wi = __expf(li - mt), wo = __expf(lf + m0 - mt);
    const float sv = qk * wi, den = sv + wo * qn, inv = 1.0f / fmaxf(fabsf(den), __expf(-mt));
    const int col4 = tid & 127, dg = tid >> 7;
    const f32x4* Cin = (const f32x4*)(stC + (size_t)unit * 131072); f32x4* Cout = (f32x4*)(sC + (size_t)unit * 131072);
    const f32x4 v4 = *(const LAS f32x4*)(vs + 4 * col4);
    f32x4 acc = (f32x4){0.f, 0.f, 0.f, 0.f};
#pragma unroll 1
    for (int it = 0; it < 64; it += 8) { f32x4 cv[8];
#pragma unroll
        for (int u = 0; u < 8; ++u) cv[u] = __builtin_nontemporal_load(Cin + (size_t)(4 * (it + u) + dg) * 128 + col4);
#pragma unroll
        for (int u = 0; u < 8; ++u) { const int d = 4 * (it + u) + dg; const float qd = qs[d], kd = ks[d] * wi; acc += cv[u] * qd;
            __builtin_nontemporal_store(cv[u] * wo + v4 * kd, Cout + (size_t)d * 128 + col4); } }
    red4[dg * 128 + col4] = acc;
    __syncthreads();
    float ss = 0.f;
    if (dg == 0) { const f32x4 tot = (red4[col4] + red4[128 + col4]) + (red4[256 + col4] + red4[384 + col4]);
        const f32x4 hv = (v4 * sv + tot * wo) * inv; ss = (hv[0] * hv[0] + hv[1] * hv[1]) + (hv[2] * hv[2] + hv[3] * hv[3]);
        { u32x2 hw_; hw_.x = pk_bf16(hv[0], hv[1]); hw_.y = pk_bf16(hv[2], hv[3]); *(u32x2*)(hml + R * DM + h * 512 + 4 * col4) = hw_; } }
    ss = wave_sum(ss);
    if (lane == 0 && w < 2 && atom) atomicAdd(ssqA + R * 4 + h, (u64)(ss * SSQ_SCALE));
    if (tid < 256) sn[(size_t)unit * 256 + tid] = wo * ns[tid] + wi * ks[tid];
    if (tid == 0) sm[unit] = mt;
    __syncthreads();
}
DI void ssd_decode_unit(LAS unsigned char* lds, int unit, const bf16* proj, const bf16* XA, const float* gsm, const float* dt_bias, const float* A_log, const float* Dsk,
                        const float* stS, bf16* ys, u64* ssqB, float* sS, bool atom) {
    int tid_ = threadIdx.x; asm volatile("" : "+v"(tid_)); const int tid = tid_, lane = tid & 63, w = __builtin_amdgcn_readfirstlane(tid >> 6);
    const int bs = unit >> 2, head = 8 * (unit & 3) + w, g = head >> 4; const size_t R = (size_t)NPROMPT + bs;
    LAS float* xs = (LAS float*)(lds + w * 2048); LAS float* Bv = xs + 64; LAS float* Cv = Bv + 128;
    const bf16* xr = XA + R * XBC;
    xs[lane] = bf2f(xr[head * 64 + lane]);
    Bv[lane] = bf2f(xr[2048 + g * 128 + lane]); Bv[lane + 64] = bf2f(xr[2048 + g * 128 + 64 + lane]);
    Cv[lane] = bf2f(xr[2304 + g * 128 + lane]); Cv[lane + 64] = bf2f(xr[2304 + g * 128 + 64 + lane]);
    asm volatile("s_waitcnt lgkmcnt(0)" ::: "memory");
    const float cbdot = wave_sum(Cv[lane] * Bv[lane] + Cv[lane + 64] * Bv[lane + 64]);
    const float dt = softplus_f(gsm[R * 64 + 8 + head] + dt_bias[head]), ea = __expf(-dt * __expf(A_log[head])), Dk = Dsk[head];
    const int n4 = lane & 31, prow = lane >> 5;
    const f32x4 B4 = *(const LAS f32x4*)(Bv + 4 * n4), C4 = *(const LAS f32x4*)(Cv + 4 * n4);
    const f32x4* Sin = (const f32x4*)(stS + ((size_t)bs * 32 + head) * 8192); f32x4* Sout = (f32x4*)(sS + ((size_t)bs * 32 + head) * 8192);
    float ss = 0.f;
#pragma unroll 1
    for (int it = 0; it < 32; it += 8) { f32x4 sv[8];
#pragma unroll
        for (int u = 0; u < 8; ++u) sv[u] = __builtin_nontemporal_load(Sin + (size_t)(2 * (it + u) + prow) * 32 + n4);
#pragma unroll
        for (int u = 0; u < 8; ++u) { const int p = 2 * (it + u) + prow; const float xp = xs[p];
            __builtin_nontemporal_store(sv[u] * ea + B4 * (dt * xp), Sout + (size_t)p * 32 + n4);
            float y2 = (C4[0] * sv[u][0] + C4[1] * sv[u][1]) + (C4[2] * sv[u][2] + C4[3] * sv[u][3]);
#pragma unroll
            for (int o = 1; o < 32; o <<= 1) y2 += __shfl_xor(y2, o);
            const float z = bf2f(proj[R * LDP + PZ + head * 64 + p]);
            const float yv = (cbdot * dt * xp + ea * y2 + Dk * xp) * silu_f(z);
            if (n4 == 0) { ys[R * DM + head * 64 + p] = f2bf(yv); ss += yv * yv; } } }
    ss += __shfl_xor(ss, 32);
    if (lane == 0 && atom) atomicAdd(ssqB + R * 2 + g, (u64)(ss * SSQ_SCALE));
}

DI void merge_phase(const Args& a, int vcu, int G) {
    int tid_ = threadIdx.x; asm volatile("" : "+v"(tid_)); const int tid = tid_, lane = tid & 63, wave = __builtin_amdgcn_readfirstlane(tid >> 6);
    unsigned char* ws = a.ws;
    const bf16* proj = (const bf16*)(ws + WS_PROJ); const bf16* hml = (const bf16*)(ws + WS_HML); const bf16* ys = (const bf16*)(ws + WS_YS);
    const u64* ssqA = (const u64*)(ws + WS_SSQ) + SSQA; const u64* ssqB = (const u64*)(ws + WS_SSQ) + SSQB;
    bf16* mg = (bf16*)(ws + WS_MERGED); const float* hnw = a.in[15]; const float* snw = a.in[21];
    const int gw = vcu * NWAVES + wave, NGW = G * NWAVES;
    for (int row = gw; row < NTOK; row += NGW) {
        float rA[4], rB[2];
#pragma unroll
        for (int i = 0; i < 4; ++i) rA[i] = rs_from(ssqA, row * 4 + i, 1.0f / 512.0f);
#pragma unroll
        for (int i = 0; i < 2; ++i) rB[i] = rs_from(ssqB, row * 2 + i, 1.0f / 1024.0f);
#pragma unroll
        for (int it = 0; it < 8; ++it) { const int c = 4 * lane + 256 * it;
            const u32x2 hr = *(const u32x2*)(hml + (size_t)row * DM + c), yr = *(const u32x2*)(ys + (size_t)row * DM + c); const f32x4 hw = *(const f32x4*)(hnw + c), sw = *(const f32x4*)(snw + c);
            const f32x4 hv = (f32x4){__uint_as_float(hr.x << 16), __uint_as_float(hr.x & 0xffff0000u), __uint_as_float(hr.y << 16), __uint_as_float(hr.y & 0xffff0000u)}, yv = (f32x4){__uint_as_float(yr.x << 16), __uint_as_float(yr.x & 0xffff0000u), __uint_as_float(yr.y << 16), __uint_as_float(yr.y & 0xffff0000u)};
            const u32x2 og = *(const u32x2*)(proj + (size_t)row * LDP + POG + c), ga = *(const u32x2*)(proj + (size_t)row * LDP + PGATE + c), gb = *(const u32x2*)(proj + (size_t)row * LDP + PGATE + DM + c);
            float o[4];
#pragma unroll
            for (int i = 0; i < 4; ++i) { const unsigned ow = og[i >> 1], aw = ga[i >> 1], bw = gb[i >> 1];
                const float ogf = (i & 1) ? __uint_as_float(ow & 0xffff0000u) : __uint_as_float(ow << 16), gaf = (i & 1) ? __uint_as_float(aw & 0xffff0000u) : __uint_as_float(aw << 16), gbf = (i & 1) ? __uint_as_float(bw & 0xffff0000u) : __uint_as_float(bw << 16);
                o[i] = sigm_f(gaf) * (sigm_f(ogf) * hv[i] * rA[it >> 1] * hw[i]) + sigm_f(gbf) * (yv[i] * rB[it >> 2] * sw[i]); }
            u32x2 wv; wv.x = pk_bf16(o[0], o[1]); wv.y = pk_bf16(o[2], o[3]); *(u32x2*)(mg + (size_t)row * DM + c) = wv; }
    }
    float* out = a.out; const int gt = vcu * NTHR + tid, NGT = G * NTHR;
    for (int i = gt; i < NBATCH * 3 * XBC; i += NGT) { const int ch = i % XBC, r = (i / XBC) % 3, b = i / (3 * XBC); out[O_PCONV + i] = bf2f(proj[((size_t)b * SEQ + SEQ - 3 + r) * LDP + PXBC + ch]); }
    const float* stc = a.in[2];
    for (int i = gt; i < NSAMP * 3 * XBC; i += NGT) { const int ch = i % XBC, r = (i / XBC) % 3, bs = i / (3 * XBC);
        out[O_SCONV + i] = r < 2 ? stc[(size_t)bs * 3 * XBC + (r + 1) * XBC + ch] : bf2f(proj[((size_t)NPROMPT + bs) * LDP + PXBC + ch]); }
}
DI void final_norm_phase(const Args& a, int vcu, int G) {
    int tid_ = threadIdx.x; asm volatile("" : "+v"(tid_)); const int tid = tid_, lane = tid & 63, wave = __builtin_amdgcn_readfirstlane(tid >> 6);
    const u64* ssq3 = (const u64*)(a.ws + WS_SSQ) + SSQ3; const float* fw = a.in[27]; float* out = a.out; const bf16* xb = (const bf16*)(a.ws + WS_XB);
    const int gw = vcu * NWAVES + wave, NGW = G * NWAVES;
    for (int row = gw; row < NTOK; row += NGW) { const float r = rs_from(ssq3, row, 1.0f / 2048.0f);
#pragma unroll
        for (int it = 0; it < 4; ++it) { const int c = 8 * lane + 512 * it; const u32x4 xr = *(const u32x4*)(xb + (size_t)row * DM + c);
            const f32x4 f0 = *(const f32x4*)(fw + c), f1 = *(const f32x4*)(fw + c + 4);
            const f32x4 v0 = (f32x4){__uint_as_float(xr.x << 16), __uint_as_float(xr.x & 0xffff0000u), __uint_as_float(xr.y << 16), __uint_as_float(xr.y & 0xffff0000u)};
            const f32x4 v1 = (f32x4){__uint_as_float(xr.z << 16), __uint_as_float(xr.z & 0xffff0000u), __uint_as_float(xr.w << 16), __uint_as_float(xr.w & 0xffff0000u)};
            *(f32x4*)(out + (size_t)row * DM + c) = v0 * r * f0; *(f32x4*)(out + (size_t)row * DM + c + 4) = v1 * r * f1; } }
}

template <int KSTEPS>
DI void gemm_skinny(LAS unsigned char* lds, int c, const bf16* A, const bf16* Bt, const float* res, const bf16* resb, float alpha, float* out, bf16* xb, u64* ssq) {
    int tid_ = threadIdx.x; asm volatile("" : "+v"(tid_)); const int tid = tid_, lane = tid & 63, w = __builtin_amdgcn_readfirstlane(tid >> 6), fr = lane & 15, fq = lane >> 4;
    constexpr int K = KSTEPS * 256, kw = K / 8;
    const int cb = c >> 1, r0 = 64 * (c & 1);
    const bf16* ap = A + (size_t)(NPROMPT + r0 + fr) * K + w * kw + 8 * fq;
    const bf16* bp = Bt + (size_t)(16 * cb + fr) * K + w * kw + 8 * fq;
    f32x4 acc[4];
#pragma unroll
    for (int rb = 0; rb < 4; ++rb) acc[rb] = (f32x4){0.f, 0.f, 0.f, 0.f};
#pragma unroll
    for (int k0 = 0; k0 < KSTEPS; k0 += 4) { bf16x8 bfg[4], af[4][4];
#pragma unroll
        for (int u = 0; u < 4; ++u) if (k0 + u < KSTEPS) { bfg[u] = *(const bf16x8*)(bp + 32 * (k0 + u));
#pragma unroll
            for (int rb = 0; rb < 4; ++rb) af[u][rb] = *(const bf16x8*)(ap + (size_t)rb * 16 * K + 32 * (k0 + u)); }
#pragma unroll
        for (int u = 0; u < 4; ++u) if (k0 + u < KSTEPS) {
#pragma unroll
            for (int rb = 0; rb < 4; ++rb) acc[rb] = mfma16(bfg[u], af[u][rb], acc[rb]); } }
    LAS f32x4* red = (LAS f32x4*)lds;
#pragma unroll
    for (int rb = 0; rb < 4; ++rb) red[(w * 4 + rb) * 64 + lane] = acc[rb];
    __syncthreads();
    if (w < 4) {
        f32x4 sum = red[w * 64 + lane];
#pragma unroll
        for (int w2 = 1; w2 < 8; ++w2) sum += red[(w2 * 4 + w) * 64 + lane];
        const int rl = r0 + 16 * w + fr, col = 16 * cb + 4 * fq;
        f32x4 rv;
        if (res) rv = *(const f32x4*)(res + (size_t)rl * DM + col);
        else { const u32x2 rw = *(const u32x2*)(resb + (size_t)(NPROMPT + rl) * DM + col); rv = (f32x4){__uint_as_float(rw.x << 16), __uint_as_float(rw.x & 0xffff0000u), __uint_as_float(rw.y << 16), __uint_as_float(rw.y & 0xffff0000u)}; }
        const f32x4 o = rv + sum * alpha;
        if (out) *(f32x4*)(out + (size_t)rl * DM + col) = o;
        if (xb) { u32x2 wv; wv.x = pk_bf16(o[0], o[1]); wv.y = pk_bf16(o[2], o[3]); *(u32x2*)(xb + (size_t)(NPROMPT + rl) * DM + col) = wv; }
        float ss = (o[0] * o[0] + o[1] * o[1]) + (o[2] * o[2] + o[3] * o[3]);
        ss += __shfl_xor(ss, 16); ss += __shfl_xor(ss, 32);
        if (fq == 0) atomicAdd(ssq + NPROMPT + rl, (u64)(ss * SSQ_SCALE));
    }
    __syncthreads();
}

#define XB_TMO      128
#define XB_XCNT(j)  (256  + 64 * (j))
#define XB_XSUB(j)  (1280 + 64 * (j))
#define XB_XGEN(j)  (2304 + 64 * (j))
#define XB_TOP      3328
#define XB_TOPGEN   3392
#define XCD_BAR_WORDS 3456
#define XB_SPIN_CAP (1u << 18)

__device__ __forceinline__ unsigned xb_ld(unsigned* p)              { return __hip_atomic_load(p, __ATOMIC_RELAXED, __HIP_MEMORY_SCOPE_AGENT); }
__device__ __forceinline__ unsigned xb_add(unsigned* p, unsigned v) { return __hip_atomic_fetch_add(p, v, __ATOMIC_RELAXED, __HIP_MEMORY_SCOPE_AGENT); }
__device__ __forceinline__ unsigned xb_xcc_id() { return (unsigned)__builtin_amdgcn_s_getreg((3 << 11) | 20) & 0xFu; }
#define XB_SPIN(cond, bar) do { unsigned _sp = 0; while (cond) { __builtin_amdgcn_s_sleep(1); \
    if ((++_sp & 255u) == 0u) { if (xb_ld(&(bar)[XB_TMO])) break; if (_sp > XB_SPIN_CAP) { atomicAdd(&(bar)[XB_TMO], 1u); break; } } } } while (0)

struct XcdBarrier {
    unsigned* bar; unsigned x;
    volatile LAS unsigned* st;
};

__device__ __forceinline__ XcdBarrier xcd_barrier_post(unsigned* bar, volatile LAS unsigned* st) {
    XcdBarrier b; b.bar = bar; b.x = xb_xcc_id(); b.st = st;
    if (threadIdx.x == 0) (void)xb_add(&bar[XB_XCNT(b.x)], 1u);
    return b;
}
__device__ __forceinline__ void xcd_barrier_complete(unsigned* bar, unsigned x, unsigned& nloc, unsigned& nx) {
    const unsigned G = gridDim.x * gridDim.y * gridDim.z;
    unsigned sum, cnt, mine, sp = 0u;
    for (;;) {
        sum = 0u; cnt = 0u; mine = 0u;
#pragma unroll
        for (unsigned j = 0; j < 16; ++j) { const unsigned c = xb_ld(&bar[XB_XCNT(j)]); sum += c; cnt += (c > 0u) ? 1u : 0u; mine = (j == x) ? c : mine; }
        if (sum == G) break;
        __builtin_amdgcn_s_sleep(1);
        if ((++sp & 255u) == 0u) { if (xb_ld(&bar[XB_TMO])) break; if (sp > XB_SPIN_CAP) { atomicAdd(&bar[XB_TMO], 1u); break; } }
    }
    nloc = mine > 0u ? mine : 1u; nx = cnt > 0u ? cnt : 1u;
}

__device__ __forceinline__ void xcd_barrier(const XcdBarrier& b) {
    asm volatile("s_waitcnt vmcnt(0)" ::: "memory");
    __syncthreads();
    if (threadIdx.x == 0) {
        unsigned* bar = b.bar;
        __builtin_amdgcn_s_waitcnt(0);
        unsigned nloc = b.st[0], nx = b.st[1];
        if (nloc == 0u) { xcd_barrier_complete(bar, b.x, nloc, nx); b.st[0] = nloc; b.st[1] = nx; }
        const unsigned old = xb_add(&bar[XB_XSUB(b.x)], 1u);
        const unsigned gen = old / nloc;
        if (old + 1u == (gen + 1u) * nloc) {
            __builtin_amdgcn_fence(__ATOMIC_RELEASE, "agent");
            asm volatile("s_waitcnt vmcnt(0)" ::: "memory");
            const unsigned og = xb_add(&bar[XB_TOP], 1u);
            const unsigned tg = og / nx;
            if (og + 1u == (tg + 1u) * nx) xb_add(&bar[XB_TOPGEN], 1u);
            else XB_SPIN(xb_ld(&bar[XB_TOPGEN]) == tg, bar);
            __builtin_amdgcn_fence(__ATOMIC_ACQUIRE, "agent");
            xb_add(&bar[XB_XGEN(b.x)], 1u);
            asm volatile("s_waitcnt vmcnt(0)" ::: "memory");
        } else {
            XB_SPIN(xb_ld(&bar[XB_XGEN(b.x)]) == gen, bar);
            __builtin_amdgcn_fence(__ATOMIC_ACQUIRE, "agent");
            asm volatile("s_waitcnt vmcnt(0)" ::: "memory");
        }
    }
    __syncthreads();
}


__global__ void __launch_bounds__(NTHR, 2) hybrid_fwd(Args a) {
    extern __shared__ __attribute__((aligned(16))) unsigned char lds_raw[];
    LAS unsigned char* lds = (LAS unsigned char*)lds_raw;
    cg::grid_group grid = cg::this_grid();
    const int G = gridDim.x, bx = blockIdx.x;
    const int vcu = (G % 8 == 0) ? (bx % 8) * (G / 8) + bx / 8 : bx;
    unsigned char* ws = a.ws;
    volatile LAS unsigned* bst = (volatile LAS unsigned*)(lds + LDS_BYTES - 16);
    if (threadIdx.x < 4) bst[threadIdx.x] = 0u;
    __syncthreads();
    XcdBarrier xbar = xcd_barrier_post((unsigned*)(ws + WS_BAR), bst);
    u64* ssq = (u64*)(ws + WS_SSQ);
    bf16* xb = (bf16*)(ws + WS_XB); bf16* Hb = (bf16*)(ws + WS_H); bf16* proj = (bf16*)(ws + WS_PROJ); bf16* mg = (bf16*)(ws + WS_MERGED);
    float* gsm = (float*)(ws + WS_GSM); bf16* hml = (bf16*)(ws + WS_HML); bf16* ysb = (bf16*)(ws + WS_YS);

    if (a.out == nullptr) grid.sync();
    p0_prologue(lds, a, vcu, G);
    xcd_barrier(xbar);
    {
        pg8::Gemm g{xb, (const bf16*)(ws + WS_WGU1), MP, NGU, DM}; pg8::StaticOrder S; S.init(MP, NGU, G, bx);
        pg8::EpiSwiGLU E{Hb, FF, ssq + SSQ0};
        pg8::gemm_phase<pg8::EpiSwiGLU, pg8::StaticOrder, true, true>(lds, g, S, E);
        { const int nfull = (MP / 256) * (NGU / 256) % G;
          if (nfull && bx >= nfull) convert_items(lds, a, CV_PROLOGUE_END, CV_G1TAIL_END, (bx - nfull) * NWAVES + __builtin_amdgcn_readfirstlane((int)(threadIdx.x >> 6)), (G - nfull) * NWAVES); }
    }
    xcd_barrier(xbar);
    {
        pg8::Gemm g{Hb, (const bf16*)(ws + WS_WD1), NPROMPT, DM, FF}; pg8::StaticOrder S; S.init(NPROMPT, DM, G, bx);
        pg8::EpiResid E{nullptr, xb, nullptr, xb, ssq + SSQ1, 0.5f};
        pg8::gemm_phase<pg8::EpiResid, pg8::StaticOrder, true, true>(lds, g, S, E);
        for (int c = vcu; c < 256; c += G) gemm_skinny<FF / 256>(lds, c, Hb, (const bf16*)(ws + WS_WD1), nullptr, xb, 0.5f, nullptr, xb, ssq + SSQ1);
    }
    xcd_barrier(xbar);
    {
        pg8::Gemm g{xb, (const bf16*)(ws + WS_WIN), MP, NPROJ, DM}; pg8::StaticOrder S; S.init(MP, NPROJ, G, bx);
        pg8::EpiProj E{proj, LDP, gsm, ssq + SSQ1, LDP / 256};
        pg8::gemm_phase<pg8::EpiProj, pg8::StaticOrder, true, true>(lds, g, S, E);
        { const int nfull = (MP / 256) * (NPROJ / 256) % G;
          if (nfull && bx >= nfull) convert_items(lds, a, CV_G1TAIL_END, CV_END, (bx - nfull) * NWAVES + __builtin_amdgcn_readfirstlane((int)(threadIdx.x >> 6)), (G - nfull) * NWAVES); }
    }
    xcd_barrier(xbar);
    {
        float* out = a.out; const bf16* XA = (const bf16*)(ws + WS_XA);
        unsigned* qctr = (unsigned*)(ws + WS_BAR) + XCD_BAR_WORDS;
        const bool split = (G == 256);
        bool conv_seen = !split;
        if (!split) { conv_pass(a, vcu, G); xcd_barrier(xbar); }
        else if (vcu >= 128) {
            conv_pass(a, vcu - 128, 128);
            asm volatile("s_waitcnt vmcnt(0)" ::: "memory"); __syncthreads();
            if (threadIdx.x == 0) { __builtin_amdgcn_fence(__ATOMIC_RELEASE, "agent"); asm volatile("s_waitcnt vmcnt(0)" ::: "memory");
                __hip_atomic_fetch_add(qctr + 32, 1u, __ATOMIC_RELAXED, __HIP_MEMORY_SCOPE_AGENT); }
        }
#define WAIT_CONV() do { if (!conv_seen) { if (threadIdx.x == 0) { unsigned sp_ = 0u; \
            while (__hip_atomic_load(qctr + 32, __ATOMIC_RELAXED, __HIP_MEMORY_SCOPE_AGENT) < 128u) { __builtin_amdgcn_s_sleep(2); if (++sp_ > (1u << 22)) break; } \
            __builtin_amdgcn_fence(__ATOMIC_ACQUIRE, "agent"); asm volatile("s_waitcnt vmcnt(0)" ::: "memory"); } \
            __syncthreads(); conv_seen = true; } } while (0)
        for (int u = vcu; u < 256; u += G) {
            if (u < 128) mlstm_prompt_unit(lds, u, proj, gsm, a.in[13], a.in[14], hml, ssq + SSQA, out + O_PC, out + O_PN, out + O_PM, true);
            else { WAIT_CONV(); ssd_prompt_unit(lds, u - 128, proj, XA, gsm, a.in[18], a.in[19], a.in[20], ysb, ssq + SSQB, out + O_PSSM, true); } }
        for (;;) {
            if (threadIdx.x == 0) bst[2] = atomicAdd(qctr, 1u);
            __syncthreads();
            const int u = (int)bst[2];
            __syncthreads();
            if (u >= 1024) break;
            if (u < 512) mlstm_decode_unit(lds, u, proj, gsm, a.in[13], a.in[14], a.in[3], a.in[4], a.in[5], hml, ssq + SSQA, out + O_SC, out + O_SN, out + O_SM, true);
            else { WAIT_CONV(); ssd_decode_unit(lds, u - 512, proj, XA, gsm, a.in[18], a.in[19], a.in[20], a.in[6], ysb, ssq + SSQB, out + O_SSSM, true); }
        }
#undef WAIT_CONV
    }
    xcd_barrier(xbar);
    merge_phase(a, vcu, G);
    xcd_barrier(xbar);
    {
        pg8::Gemm g{mg, (const bf16*)(ws + WS_WOUT), NPROMPT, DM, DM}; pg8::StaticOrder S; S.init(NPROMPT, DM, G, bx);
        pg8::EpiResid E{nullptr, xb, nullptr, xb, ssq + SSQ2, 1.0f};
        pg8::gemm_phase<pg8::EpiResid, pg8::StaticOrder, true, true>(lds, g, S, E);
        for (int c = vcu; c < 256; c += G) gemm_skinny<DM / 256>(lds, c, mg, (const bf16*)(ws + WS_WOUT), nullptr, xb, 1.0f, nullptr, xb, ssq + SSQ2);
    }
    xcd_barrier(xbar);
    {
        pg8::Gemm g{xb, (const bf16*)(ws + WS_WGU2), MP, NGU, DM}; pg8::StaticOrder S; S.init(MP, NGU, G, bx);
        pg8::EpiSwiGLU E{Hb, FF, ssq + SSQ2};
        pg8::gemm_phase<pg8::EpiSwiGLU, pg8::StaticOrder, true, true>(lds, g, S, E);
    }
    xcd_barrier(xbar);
    {
        pg8::Gemm g{Hb, (const bf16*)(ws + WS_WD2), NPROMPT, DM, FF}; pg8::StaticOrder S; S.init(NPROMPT, DM, G, bx);
        pg8::EpiResid E{nullptr, xb, nullptr, xb, ssq + SSQ3, 0.5f};
        pg8::gemm_phase<pg8::EpiResid, pg8::StaticOrder, true, true>(lds, g, S, E);
        for (int c = vcu; c < 256; c += G) gemm_skinny<FF / 256>(lds, c, Hb, (const bf16*)(ws + WS_WD2), nullptr, xb, 0.5f, nullptr, xb, ssq + SSQ3);
    }
    xcd_barrier(xbar);
    final_norm_phase(a, vcu, G);
}

extern "C" void kernel_launch(void* const* d_in, const int* in_sizes, int n_in, void* d_out, int out_size, void* d_ws, size_t ws_size, hipStream_t stream) {
    static int grid = 0;
    if (grid == 0) {
        if (n_in != 28 || ws_size < WS_END) { fprintf(stderr, "kernel_launch: unexpected inputs (n_in %d, ws %zu)\n", n_in, ws_size); grid = -1; return; }
        int dev = 0, cus = 0, per_cu = 0;
        hipGetDevice(&dev); hipDeviceGetAttribute(&cus, hipDeviceAttributeMultiprocessorCount, dev);
        if (hipFuncSetAttribute((const void*)hybrid_fwd, hipFuncAttributeMaxDynamicSharedMemorySize, LDS_BYTES) != hipSuccess) { fprintf(stderr, "kernel_launch: hipFuncSetAttribute failed\n"); grid = -1; return; }
        if (hipOccupancyMaxActiveBlocksPerMultiprocessor(&per_cu, (const void*)hybrid_fwd, NTHR, LDS_BYTES) != hipSuccess || per_cu < 1) { fprintf(stderr, "kernel_launch: occupancy query gave %d\n", per_cu); per_cu = 1; }
        (void)hipGetLastError();
        grid = cus * per_cu;
    }
    if (grid < 0) return;
    Args a{};
    for (int i = 0; i < 28; ++i) a.in[i] = (const float*)d_in[i];
    a.out = (float*)d_out; a.ws = (unsigned char*)d_ws;
    if (hipMemsetAsync((char*)d_ws + WS_BAR, 0, XCD_BAR_WORDS * 4 + 256, stream) != hipSuccess) { fprintf(stderr, "kernel_launch: memset of barrier words failed\n"); return; }
    void* args[] = {&a};
    hipError_t e = hipLaunchCooperativeKernel((const void*)hybrid_fwd, dim3(grid), dim3(NTHR), args, LDS_BYTES, stream);
    if (e != hipSuccess) fprintf(stderr, "kernel_launch: cooperative launch failed: %s (grid %d)\n", hipGetErrorString(e), grid);
}
```

```cpp
#include <hip/hip_runtime.h>
#include <hip/hip_cooperative_groups.h>
#include <cstdio>
#include <cstdint>
namespace cg = cooperative_groups;
#define DI __device__ __forceinline__
namespace pg8 {
#define PG8_LAS __attribute__((address_space(3)))
typedef unsigned short bf16_t;
typedef short bf16x8 __attribute__((ext_vector_type(8)));
typedef float f32x4 __attribute__((ext_vector_type(4)));
typedef unsigned u32x4 __attribute__((ext_vector_type(4)));
constexpr int BM = 256, BK = 64, HALF = 128, HTB = HALF * BK * 2  , STAGE_BYTES = 8 * HTB, NXCD = 8, WGM = 8;

__host__ __device__ __forceinline__ int lds_byte(int r, int c) { const int st = (r >> 4) * 2 + (c >> 5), rr = r & 15, cc = c & 31, ob = rr * 64 + cc * 2; return st * 1024 + (ob ^ (((ob >> 9) & 1) << 5)); }
__host__ __device__ __forceinline__ void stage_rc(int b, int& R, int& C) { const int st = b / 1024, sb = b % 1024, swz = sb ^ (((sb >> 9) & 1) << 5); R = (st >> 1) * 16 + swz / 64; C = (st & 1) * 32 + (swz % 64) / 2; }
__host__ __device__ __forceinline__ int perm32(int rho) { const int n = rho >> 4, i = rho & 15; return 8 * (i >> 2) + 4 * n + (i & 3); }

struct Unit { int pm, pn; };
struct Gemm { const bf16_t* A; const bf16_t* Bt; int M, N, K; };

struct StaticOrder {
    int nM, nN, nwg, G, c;
    __host__ __device__ void init(int M, int N, int G_, int c_) { nM = M / BM; nN = N / BM; nwg = nM * nN; G = G_; c = c_; }
    __host__ __device__ bool next(int i, Unit& u) const {
        const long L = (long)i * G + c; if (L >= nwg) return false;
        int wgid = (int)L; { const int q = nwg / NXCD, r = nwg % NXCD, xcd = wgid % NXCD, off = wgid / NXCD; wgid = (xcd < r ? xcd * (q + 1) : r * (q + 1) + (xcd - r) * q) + off; }
        const int nig = WGM * nN, gid = wgid / nig, fm = gid * WGM, gsz = (nM - fm) < WGM ? (nM - fm) : WGM;
        u.pm = fm + ((wgid % nig) % gsz); u.pn = (wgid % nig) / gsz; return true;
    }
    __device__ __forceinline__ void a_ready(const Unit&) const {}
    __device__ __forceinline__ void done(const Unit&) const {}
};

typedef unsigned u32x2 __attribute__((ext_vector_type(2)));
__device__ __forceinline__ unsigned pk_bf16(float lo, float hi) {
    typedef __bf16 bfx2 __attribute__((ext_vector_type(2))); typedef float fx2 __attribute__((ext_vector_type(2)));
    fx2 v = {lo, hi}; return __builtin_bit_cast(unsigned, __builtin_convertvector(v, bfx2));
}
constexpr float SSQ_SCALE = 4294967296.0f;
__device__ __forceinline__ float rs_from(const unsigned long long* ssq, int row, float inv_n) { return rsqrtf((float)ssq[row] * (inv_n / SSQ_SCALE) + 1e-6f); }
__device__ __forceinline__ float silu_f(float g) { return g * __builtin_amdgcn_rcpf(1.0f + __expf(-g)); }
__device__ __forceinline__ float sigm_f(float g) { return __builtin_amdgcn_rcpf(1.0f + __expf(-g)); }

struct EpiSwiGLU {
    static constexpr bool PERM = true, AFTER_DRAIN = false;
    bf16_t* H; int ldh; const unsigned long long* ssq;
    __device__ __forceinline__ void operator()(const f32x4 (&acc)[2][2][4][2], const Unit& u, int wr, int wc, int fr, int fq) const {
        const int row0 = u.pm * BM + wr * 64 + fr, col0 = u.pn * HALF + wc * 32 + 8 * fq;
#pragma unroll
        for (int ai = 0; ai < 2; ++ai)
#pragma unroll
            for (int m = 0; m < 4; ++m) {
                const int row = row0 + ai * HALF + m * 16; const float r = rs_from(ssq, row, 1.0f / 2048.0f);
                typedef float f32x2 __attribute__((ext_vector_type(2)));
                const float r2 = r * r, rk = r * -1.4426950408889634f;
                u32x4 w;
#pragma unroll
                for (int q = 0; q < 4; ++q) { const int n = q >> 1, i0 = 2 * (q & 1);
                    const f32x2 ag = (f32x2){acc[ai][0][m][n][i0], acc[ai][0][m][n][i0 + 1]}, au = (f32x2){acc[ai][1][m][n][i0], acc[ai][1][m][n][i0 + 1]};
                    const f32x2 t = ag * rk; f32x2 ex; ex.x = __builtin_amdgcn_exp2f(t.x); ex.y = __builtin_amdgcn_exp2f(t.y);
                    const f32x2 d = ex + 1.0f; f32x2 rc; rc.x = __builtin_amdgcn_rcpf(d.x); rc.y = __builtin_amdgcn_rcpf(d.y);
                    const f32x2 hh = ((ag * au) * r2) * rc;
                    w[q] = pk_bf16(hh.x, hh.y); }
                *(u32x4*)(H + (size_t)row * ldh + col0) = w;
            }
    }
};
struct EpiResid {
    static constexpr bool PERM = false, AFTER_DRAIN = false;
    const float* res0; const bf16_t* resb; float* out; bf16_t* xb; unsigned long long* ssq; float alpha;
    __device__ __forceinline__ void operator()(const f32x4 (&acc)[2][2][4][2], const Unit& u, int wr, int wc, int fr, int fq) const {
        const int row0 = u.pm * BM + wr * 64 + fr, col0 = u.pn * BM + wc * 32 + 4 * fq;
#pragma unroll
        for (int ai = 0; ai < 2; ++ai)
#pragma unroll
            for (int m = 0; m < 4; ++m) {
                const int row = row0 + ai * HALF + m * 16;
                float ss = 0.f;
#pragma unroll
                for (int bj = 0; bj < 2; ++bj)
#pragma unroll
                    for (int n = 0; n < 2; ++n) {
                        const size_t off = (size_t)row * 2048 + col0 + bj * HALF + n * 16;
                        f32x4 rv;
                        if (res0) rv = *(const f32x4*)(res0 + off);
                        else { const u32x2 rw = *(const u32x2*)(resb + off); rv = (f32x4){__uint_as_float(rw.x << 16), __uint_as_float(rw.x & 0xffff0000u), __uint_as_float(rw.y << 16), __uint_as_float(rw.y & 0xffff0000u)}; }
                        const f32x4 o = rv + acc[ai][bj][m][n] * alpha;
                        ss += (o[0] * o[0] + o[1] * o[1]) + (o[2] * o[2] + o[3] * o[3]);
                        if (out) *(f32x4*)(out + off) = o;
                        if (xb) { u32x2 w; w.x = pk_bf16(o[0], o[1]); w.y = pk_bf16(o[2], o[3]); *(u32x2*)(xb + off) = w; }
                    }
                ss += __shfl_xor(ss, 16); ss += __shfl_xor(ss, 32);
                if (fq == 0) atomicAdd(ssq + row, (unsigned long long)(ss * SSQ_SCALE));
            }
    }
};
struct EpiProj {
    static constexpr bool PERM = true, AFTER_DRAIN = false;
    bf16_t* P; int ldp; float* gsm; const unsigned long long* ssq; int n_main;
    __device__ __forceinline__ void operator()(const f32x4 (&acc)[2][2][4][2], const Unit& u, int wr, int wc, int fr, int fq) const {
        const int row0 = u.pm * BM + wr * 64 + fr;
#pragma unroll
        for (int ai = 0; ai < 2; ++ai)
#pragma unroll
            for (int m = 0; m < 4; ++m) {
                const int row = row0 + ai * HALF + m * 16; const float r = rs_from(ssq, row, 1.0f / 2048.0f);
                if (u.pn < n_main) {
                    const int col0 = u.pn * BM + wc * 32 + 8 * fq;
#pragma unroll
                    for (int bj = 0; bj < 2; ++bj) { const f32x4 v0 = acc[ai][bj][m][0] * r, v1 = acc[ai][bj][m][1] * r;
                        u32x4 w; w.x = pk_bf16(v0[0], v0[1]); w.y = pk_bf16(v0[2], v0[3]); w.z = pk_bf16(v1[0], v1[1]); w.w = pk_bf16(v1[2], v1[3]);
                        *(u32x4*)(P + (size_t)row * ldp + col0 + bj * HALF) = w; }
                } else if (wc < 2) {
                    float* gp = gsm + (size_t)row * 64 + wc * 32 + 8 * fq;
                    *(f32x4*)gp = acc[ai][0][m][0] * r; *(f32x4*)(gp + 4) = acc[ai][0][m][1] * r;
                }
            }
    }
};

template <class Epi, class Sched, bool ALIGN_EPI = false, bool SP2 = false>
__device__ __forceinline__ void gemm_phase(PG8_LAS unsigned char* lds, const Gemm g, const Sched& S, const Epi& E) {
    int tid_ = threadIdx.x; asm volatile("" : "+v"(tid_)); const int tid = tid_, wid = __builtin_amdgcn_readfirstlane(tid >> 6), lane = tid & 63, wr = wid >> 2, wc = wid & 3, fr = lane & 15, fq = lane >> 4;
    const int K = g.K, nt = K / BK;
    unsigned voffA[2], voffB[2];
#pragma unroll
    for (int i = 0; i < 2; ++i) { int R, C; stage_rc(tid * 16 + i * 8192, R, C); const int Rb = Epi::PERM ? ((R & ~31) + perm32(R & 31)) : R;
        voffA[i] = (unsigned)(R * K + C) * 2u; voffB[i] = (unsigned)(Rb * K + C) * 2u; }
    const size_t kstep = (size_t)(BK * 2);
    const size_t hstep = (size_t)HALF * K * 2;
    const size_t tstep = 2 * hstep;
    const unsigned ldsw = (unsigned)wid * 1024u;
    const int aoff = lds_byte(wr * 64 + fr, fq * 8), boff = lds_byte(wc * 32 + fr, fq * 8);
#define PG8_SA(b, h) (((b) * 2 + (h)) * HTB)
#define PG8_SB(b, h) ((4 + (b) * 2 + (h)) * HTB)
#define PG8_STAGE(bufoff, gbase, voff) do { _Pragma("unroll") for (int _i = 0; _i < 2; ++_i) \
        __builtin_amdgcn_global_load_lds((const unsigned*)((const char*)(gbase) + (voff)[_i]), (PG8_LAS unsigned*)(lds + (bufoff) + ldsw + _i * 8192), 16, 0, 0); } while (0)
#define PG8_LDA(dst, b, h) do { _Pragma("unroll") for (int m = 0; m < 4; ++m) _Pragma("unroll") for (int k = 0; k < 2; ++k) dst[m][k] = *(const PG8_LAS bf16x8*)(lds + PG8_SA(b, h) + aoff + m * 2048 + k * 1024); } while (0)
#define PG8_LDB(dst, b, h) do { _Pragma("unroll") for (int n = 0; n < 2; ++n) _Pragma("unroll") for (int k = 0; k < 2; ++k) dst[n][k] = *(const PG8_LAS bf16x8*)(lds + PG8_SB(b, h) + boff + n * 2048 + k * 1024); } while (0)
#define PG8_MMA(ai, bj, At, Bt) do { __builtin_amdgcn_s_setprio(1); _Pragma("unroll") for (int m = 0; m < 4; ++m) _Pragma("unroll") for (int n = 0; n < 2; ++n) _Pragma("unroll") for (int k = 0; k < 2; ++k) \
        acc[ai][bj][m][n] = __builtin_amdgcn_mfma_f32_16x16x32_bf16(Bt[n][k], At[m][k], acc[ai][bj][m][n], 0, 0, 0); __builtin_amdgcn_s_setprio(0); } while (0)
#define PG8_WAIT_V(n) asm volatile("s_waitcnt vmcnt(" #n ")" ::: "memory")
#define PG8_WAIT_L(n) asm volatile("s_waitcnt lgkmcnt(" #n ")" ::: "memory")
#define PG8_BAR __builtin_amdgcn_s_barrier()
#define PG8_SCHED __builtin_amdgcn_sched_barrier(0)
    Unit cur, nxt; int ui = 0;
    if (!S.next(0, cur)) return;
    f32x4 acc[2][2][4][2];
#pragma unroll
    for (int a = 0; a < 2; ++a)
#pragma unroll
        for (int b = 0; b < 2; ++b)
#pragma unroll
            for (int m = 0; m < 4; ++m)
#pragma unroll
                for (int n = 0; n < 2; ++n) acc[a][b][m][n] = (f32x4){0.f, 0.f, 0.f, 0.f};
    bf16x8 At[4][2], B0[2][2], B1[2][2];
    const char* cA = (const char*)g.A + (size_t)cur.pm * tstep; const char* cB = (const char*)g.Bt + (size_t)cur.pn * tstep;
    S.a_ready(cur);
    if constexpr (SP2) {
        PG8_STAGE(PG8_SB(0, 0), cB, voffB); PG8_STAGE(PG8_SB(0, 1), cB + hstep, voffB); PG8_STAGE(PG8_SA(0, 0), cA, voffA); PG8_STAGE(PG8_SA(0, 1), cA + hstep, voffA);
        if (wr == 1) PG8_BAR;
        PG8_WAIT_V(2); PG8_BAR;
        PG8_STAGE(PG8_SB(1, 0), cB + kstep, voffB); PG8_STAGE(PG8_SA(1, 0), cA + kstep, voffA); PG8_STAGE(PG8_SB(1, 1), cB + hstep + kstep, voffB);
        PG8_WAIT_V(6); PG8_BAR;
    } else {
        PG8_STAGE(PG8_SB(0, 0), cB, voffB); PG8_STAGE(PG8_SA(0, 0), cA, voffA); PG8_STAGE(PG8_SB(0, 1), cB + hstep, voffB); PG8_STAGE(PG8_SA(0, 1), cA + hstep, voffA);
        if (wr == 1) PG8_BAR;
        PG8_WAIT_V(4); PG8_BAR;
        PG8_STAGE(PG8_SB(1, 0), cB + kstep, voffB); PG8_STAGE(PG8_SA(1, 0), cA + kstep, voffA); PG8_STAGE(PG8_SB(1, 1), cB + hstep + kstep, voffB);
        PG8_WAIT_V(6); PG8_BAR;
    }
    for (;;) {
        const bool has_next = S.next(ui + 1, nxt);
        const char* nA = has_next ? (const char*)g.A + (size_t)nxt.pm * tstep : cA; const char* nB = has_next ? (const char*)g.Bt + (size_t)nxt.pn * tstep : cB;
        for (int t = 0; t < nt; t += 2) {
            const bool last = (t == nt - 2);
            const char* a1 = cA + (size_t)(t + 1) * kstep;
            const char* a2 = last ? nA : cA + (size_t)(t + 2) * kstep; const char* b2 = last ? nB : cB + (size_t)(t + 2) * kstep;
            const char* a3 = a2 + kstep; const char* b3 = b2 + kstep;
            if (last && has_next) S.a_ready(nxt);
            if constexpr (SP2) {
            PG8_LDB(B0, 0, 0); PG8_LDB(B1, 0, 1); PG8_SCHED; PG8_LDA(At, 0, 0); PG8_STAGE(PG8_SA(1, 1), a1 + hstep, voffA);
            PG8_WAIT_V(8); PG8_WAIT_L(0); PG8_BAR; PG8_MMA(0, 0, At, B0); PG8_MMA(0, 1, At, B1); PG8_BAR; PG8_SCHED;
            PG8_LDA(At, 0, 1); PG8_STAGE(PG8_SB(0, 0), b2, voffB); PG8_STAGE(PG8_SB(0, 1), b2 + hstep, voffB); PG8_STAGE(PG8_SA(0, 0), a2, voffA);
            PG8_WAIT_V(8); PG8_WAIT_L(0); PG8_BAR; PG8_MMA(1, 0, At, B0); PG8_MMA(1, 1, At, B1); PG8_BAR; PG8_SCHED;
            PG8_LDB(B0, 1, 0); PG8_LDB(B1, 1, 1); PG8_SCHED; PG8_LDA(At, 1, 0); PG8_STAGE(PG8_SA(0, 1), a2 + hstep, voffA);
            PG8_WAIT_V(8); PG8_WAIT_L(0); PG8_BAR; PG8_MMA(0, 0, At, B0); PG8_MMA(0, 1, At, B1); PG8_BAR; PG8_SCHED;
            PG8_LDA(At, 1, 1); PG8_STAGE(PG8_SB(1, 0), b3, voffB); PG8_STAGE(PG8_SB(1, 1), b3 + hstep, voffB); PG8_STAGE(PG8_SA(1, 0), a3, voffA);
            PG8_WAIT_V(8); PG8_WAIT_L(0); PG8_BAR; PG8_MMA(1, 0, At, B0); PG8_MMA(1, 1, At, B1); PG8_BAR; PG8_SCHED;
            } else {
            PG8_LDB(B0, 0, 0); PG8_SCHED; PG8_LDA(At, 0, 0); PG8_STAGE(PG8_SA(1, 1), a1 + hstep, voffA);
            PG8_WAIT_L(8); PG8_BAR; PG8_WAIT_L(0); PG8_MMA(0, 0, At, B0); PG8_BAR; PG8_SCHED;
            PG8_LDB(B1, 0, 1); PG8_STAGE(PG8_SB(0, 0), b2, voffB);
            PG8_BAR; PG8_WAIT_L(0); PG8_MMA(0, 1, At, B1); PG8_BAR;
            PG8_LDA(At, 0, 1); PG8_STAGE(PG8_SA(0, 0), a2, voffA);
            PG8_BAR; PG8_WAIT_L(0); PG8_MMA(1, 0, At, B0); PG8_BAR; PG8_SCHED;
            PG8_STAGE(PG8_SB(0, 1), b2 + hstep, voffB);
            PG8_WAIT_V(6); PG8_BAR; PG8_MMA(1, 1, At, B1); PG8_BAR;
            PG8_LDB(B0, 1, 0); PG8_SCHED; PG8_LDA(At, 1, 0); PG8_STAGE(PG8_SA(0, 1), a2 + hstep, voffA);
            PG8_WAIT_L(8); PG8_BAR; PG8_WAIT_L(0); PG8_MMA(0, 0, At, B0); PG8_BAR; PG8_SCHED;
            PG8_LDB(B1, 1, 1); PG8_STAGE(PG8_SB(1, 0), b3, voffB);
            PG8_BAR; PG8_WAIT_L(0); PG8_MMA(0, 1, At, B1); PG8_BAR;
            PG8_LDA(At, 1, 1); PG8_STAGE(PG8_SA(1, 0), a3, voffA);
            PG8_BAR; PG8_WAIT_L(0); PG8_MMA(1, 0, At, B0); PG8_BAR; PG8_SCHED;
            PG8_STAGE(PG8_SB(1, 1), b3 + hstep, voffB);
            PG8_WAIT_V(6); PG8_BAR; PG8_MMA(1, 1, At, B1); PG8_BAR;
            }
        }
        if constexpr (ALIGN_EPI) { if (wr == 0) PG8_BAR; }
        if constexpr (!Epi::AFTER_DRAIN) { E(acc, cur, wr, wc, fr, fq); S.done(cur); }
        if (!has_next) break;
#pragma unroll
        for (int a = 0; a < 2; ++a)
#pragma unroll
            for (int b = 0; b < 2; ++b)
#pragma unroll
                for (int m = 0; m < 4; ++m)
#pragma unroll
                    for (int n = 0; n < 2; ++n) acc[a][b][m][n] = (f32x4){0.f, 0.f, 0.f, 0.f};
        cur = nxt; cA = nA; cB = nB; ++ui;
        if constexpr (ALIGN_EPI) { if (wr == 1) PG8_BAR; }
    }
    PG8_WAIT_V(0);
    if constexpr (!ALIGN_EPI) { if (wr == 0) PG8_BAR; }
    PG8_BAR;
    if constexpr (Epi::AFTER_DRAIN) { E.fused(acc, cur, wr, wc, fr, fq, lds, wid, lane); S.done(cur); }
#undef PG8_SA
#undef PG8_SB
#undef PG8_STAGE
#undef PG8_LDA
#undef PG8_LDB
#undef PG8_MMA
#undef PG8_WAIT_V
#undef PG8_WAIT_L
#undef PG8_BAR
#undef PG8_SCHED
}
}

constexpr int DM = 2048, FF = 5632, NPROMPT = 8192, NSAMP = 128, NTOK = 8320, MP = 8448, SEQ = 2048, NBATCH = 4;
constexpr int NGU = 2 * FF;
constexpr int LDP = 14848;
constexpr int NPROJ = 15104;
constexpr int PQ = 0, PK = 1024, PV = 2048, POG = 4096, PZ = 6144, PXBC = 8192, PGATE = 10752;
constexpr int XBC = 2560, IN_DIM = 14888;
constexpr float NEG_INIT = -1e30f;
constexpr size_t O_Y = 0, O_PCONV = 17039360, O_PC = 17070080, O_PN = 19167232, O_PM = 19171328, O_PSSM = 19171344,
                 O_SCONV = 20219920, O_SC = 21202960, O_SN = 88311824, O_SM = 88442896, O_SSSM = 88443408;
constexpr size_t MiB = 1u << 20;
constexpr size_t WS_SSQ = 0, WS_BAR = 1 * MiB, WS_WGU1 = 2 * MiB, WS_WD1 = 46 * MiB, WS_WIN = 68 * MiB, WS_WOUT = 127 * MiB, WS_WGU2 = 135 * MiB, WS_WD2 = 179 * MiB,
                 WS_XB = 202 * MiB, WS_MERGED = 235 * MiB, WS_X1 = 268 * MiB, WS_H = 334 * MiB, WS_PROJ = 425 * MiB, WS_GSM = 665 * MiB, WS_HML = 668 * MiB, WS_YS = 734 * MiB, WS_XA = 800 * MiB, WS_END = 844 * MiB;
constexpr int SSQ0 = 0, SSQ1 = MP, SSQ2 = 2 * MP, SSQ3 = 3 * MP, SSQA = 4 * MP, SSQB = 8 * MP, SSQ_WORDS = 10 * MP;
constexpr int LDS_BYTES = 163840;
constexpr int NWAVES = 8, NTHR = 512;

#define LAS __attribute__((address_space(3)))
typedef unsigned short bf16;
typedef float f32x4 __attribute__((ext_vector_type(4)));
typedef short bf16x8 __attribute__((ext_vector_type(8)));
typedef unsigned u32x4 __attribute__((ext_vector_type(4)));
typedef unsigned u32x2 __attribute__((ext_vector_type(2)));
typedef unsigned long long u64;
typedef float f32x2 __attribute__((ext_vector_type(2)));
using pg8::pk_bf16; using pg8::SSQ_SCALE; using pg8::rs_from; using pg8::silu_f; using pg8::sigm_f;
DI float bf2f(unsigned v) { return __uint_as_float(v << 16); }
DI bf16 f2bf(float f) { return (bf16)(pk_bf16(f, 0.f) & 0xffffu); }
DI float wave_sum(float v) {
#pragma unroll
    for (int o = 1; o < 64; o <<= 1) v += __shfl_xor(v, o);
    return v;
}
typedef short s16x4 __attribute__((ext_vector_type(4)));
DI s16x4 lds_tr4(const LAS unsigned short* p) { return __builtin_amdgcn_ds_read_tr16_b64_v4i16((LAS s16x4*)p); }
DI f32x4 mfma16(bf16x8 a, bf16x8 b, f32x4 c) { return __builtin_amdgcn_mfma_f32_16x16x32_bf16(a, b, c, 0, 0, 0); }
DI float log_sigmoid(float x) { return fminf(x, 0.f) - log1pf(__expf(-fabsf(x))); }
DI float softplus_f(float x) { return fmaxf(x, 0.f) + log1pf(__expf(-fabsf(x))); }

struct Args { const float* in[28]; float* out; unsigned char* ws; };

DI int map_in(int n) {
    if (n < 4096) return n;
    if (n < 4100) return 14848 + (n - 4096);
    if (n < 4104) return 14852 + (n - 4100);
    if (n < 6152) return POG + (n - 4104);
    if (n < 8200) return PZ + (n - 6152);
    if (n < 10760) return PXBC + (n - 8200);
    if (n < 10792) return 14856 + (n - 10760);
    return PGATE + (n - 10792);
}
struct TItem { const float* W; bf16* WT; const float* wk; int K, N, mode, k0, n0; };
DI TItem decode_item(const Args& a, int it) {
    constexpr int I_G = (DM / 64) * (FF / 64), I_D = (FF / 64) * (DM / 64), I_IN = (DM / 64) * ((IN_DIM + 63) / 64), I_O = (DM / 64) * (DM / 64);
    unsigned char* ws = a.ws; TItem d; int r = it, nblk;
    if (r < I_G) { d.W = a.in[8]; d.WT = (bf16*)(ws + WS_WGU1); d.wk = a.in[7]; d.K = DM; d.N = FF; d.mode = 1; }
    else if ((r -= I_G) < I_G) { d.W = a.in[9]; d.WT = (bf16*)(ws + WS_WGU1); d.wk = a.in[7]; d.K = DM; d.N = FF; d.mode = 2; }
    else if ((r -= I_G) < I_IN) { d.W = a.in[12]; d.WT = (bf16*)(ws + WS_WIN); d.wk = a.in[11]; d.K = DM; d.N = IN_DIM; d.mode = 3; }
    else if ((r -= I_IN) < I_D) { d.W = a.in[10]; d.WT = (bf16*)(ws + WS_WD1); d.wk = nullptr; d.K = FF; d.N = DM; d.mode = 0; }
    else if ((r -= I_D) < I_G) { d.W = a.in[24]; d.WT = (bf16*)(ws + WS_WGU2); d.wk = a.in[23]; d.K = DM; d.N = FF; d.mode = 1; }
    else if ((r -= I_G) < I_O) { d.W = a.in[22]; d.WT = (bf16*)(ws + WS_WOUT); d.wk = nullptr; d.K = DM; d.N = DM; d.mode = 0; }
    else if ((r -= I_O) < I_D) { d.W = a.in[26]; d.WT = (bf16*)(ws + WS_WD2); d.wk = nullptr; d.K = FF; d.N = DM; d.mode = 0; }
    else { r -= I_D; d.W = a.in[25]; d.WT = (bf16*)(ws + WS_WGU2); d.wk = a.in[23]; d.K = DM; d.N = FF; d.mode = 2; }
    nblk = (d.N + 63) / 64; d.k0 = 64 * (r / nblk); d.n0 = 64 * (r % nblk);
    return d;
}
DI void titem_load(const TItem& d, f32x4 (&v)[16], float (&kw)[16], int lane) {
    const int n = d.n0 + 4 * (lane & 15), kq = lane >> 4; const bool ok = n < d.N;
#pragma unroll
    for (int i = 0; i < 16; ++i) { v[i] = (f32x4){0.f, 0.f, 0.f, 0.f}; if (ok) v[i] = __builtin_nontemporal_load((const f32x4*)(d.W + (size_t)(d.k0 + 4 * i + kq) * d.N + n)); }
#pragma unroll
    for (int i = 0; i < 16; ++i) kw[i] = d.wk ? d.wk[d.k0 + 4 * i + kq] : 1.f;
}
DI void titem_store(const TItem& d, const f32x4 (&v)[16], const float (&kw)[16], LAS float* scr, int lane) {
    const int kq = lane >> 4, nl4 = 4 * (lane & 15);
#pragma unroll
    for (int i = 0; i < 16; ++i) { LAS float* p = scr + (4 * i + kq) * 65 + nl4; const f32x4 x = v[i] * kw[i]; p[0] = x[0]; p[1] = x[1]; p[2] = x[2]; p[3] = x[3]; }
    asm volatile("s_waitcnt lgkmcnt(0)" ::: "memory");
    const int c = lane & 7;
#pragma unroll
    for (int j = 0; j < 8; ++j) { const int nl = (lane >> 3) + 8 * j, n = d.n0 + nl; const LAS float* s = scr + (8 * c) * 65 + nl;
        if (n < d.N) {
            int dst; float sc = 1.f;
            if (d.mode == 0) dst = n; else if (d.mode == 1) dst = (n >> 7) * 256 + (n & 127); else if (d.mode == 2) dst = (n >> 7) * 256 + 128 + (n & 127); else { dst = map_in(n); if (n < 1024) sc = 0.0625f; }
            u32x4 o; o.x = pk_bf16(s[0 * 65] * sc, s[1 * 65] * sc); o.y = pk_bf16(s[2 * 65] * sc, s[3 * 65] * sc); o.z = pk_bf16(s[4 * 65] * sc, s[5 * 65] * sc); o.w = pk_bf16(s[6 * 65] * sc, s[7 * 65] * sc);
            *(u32x4*)(d.WT + (size_t)dst * d.K + d.k0 + 8 * c) = o; } }
    asm volatile("s_waitcnt lgkmcnt(0)" ::: "memory");
}
constexpr int CV_I_G = (DM / 64) * (FF / 64), CV_I_D = (FF / 64) * (DM / 64), CV_I_IN = (DM / 64) * ((IN_DIM + 63) / 64), CV_I_O = (DM / 64) * (DM / 64);
constexpr int CV_PROLOGUE_END = 2 * CV_I_G + CV_I_IN, CV_G1TAIL_END = CV_PROLOGUE_END + CV_I_D + CV_I_G, CV_END = CV_G1TAIL_END + CV_I_O + CV_I_D + CV_I_G;
DI void convert_items(LAS unsigned char* lds, const Args& a, int first, int last, int widx, int nworkers) {
    int tid_ = threadIdx.x; asm volatile("" : "+v"(tid_)); const int tid = tid_, lane = tid & 63, wave = __builtin_amdgcn_readfirstlane(tid >> 6);
    LAS float* scr = (LAS float*)(lds + wave * 16640);
    int it = first + widx;
    if (it < last) {
        TItem d = decode_item(a, it); f32x4 cur[16]; float ckw[16];
        titem_load(d, cur, ckw, lane);
        for (;;) {
            const int itn = it + nworkers; const bool more = itn < last;
            TItem dn = d; f32x4 nxt[16]; float nkw[16];
            if (more) { dn = decode_item(a, itn); titem_load(dn, nxt, nkw, lane); }
            titem_store(d, cur, ckw, scr, lane);
            if (!more) break;
#pragma unroll
            for (int i = 0; i < 16; ++i) { cur[i] = nxt[i]; ckw[i] = nkw[i]; }
            d = dn; it = itn;
        }
    }
}
DI void p0_prologue(LAS unsigned char* lds, const Args& a, int vcu, int G) {
    int tid_ = threadIdx.x; asm volatile("" : "+v"(tid_)); const int tid = tid_, lane = tid & 63, wave = __builtin_amdgcn_readfirstlane(tid >> 6);
    unsigned char* ws = a.ws;
    LAS float* scr = (LAS float*)(lds + wave * 16640);
    const int gw = vcu * NWAVES + wave, NGW = G * NWAVES;
    { u64* q = (u64*)(ws + WS_SSQ); for (int i = (int)(blockIdx.x * NTHR + tid); i < SSQ_WORDS - MP; i += G * NTHR) q[MP + i] = 0ull; }
    constexpr int I_G = (DM / 64) * (FF / 64), I_D = (FF / 64) * (DM / 64), I_IN = (DM / 64) * ((IN_DIM + 63) / 64), I_O = (DM / 64) * (DM / 64);
    constexpr int NITEMS = 4 * I_G + 2 * I_D + I_IN + I_O;
    bf16* xb = (bf16*)(ws + WS_XB); u64* ssq0 = (u64*)(ws + WS_SSQ) + SSQ0;
    for (int m = gw; m < NTOK; m += NGW) {
        const float* xr = m < NPROMPT ? a.in[0] + (size_t)m * DM : a.in[1] + (size_t)(m - NPROMPT) * DM;
        f32x4 v[8];
#pragma unroll
        for (int j = 0; j < 8; ++j) v[j] = *(const f32x4*)(xr + 4 * lane + 256 * j);
        float ss = 0.f;
#pragma unroll
        for (int j = 0; j < 8; ++j) { ss += (v[j][0] * v[j][0] + v[j][1] * v[j][1]) + (v[j][2] * v[j][2] + v[j][3] * v[j][3]);
            u32x2 w; w.x = pk_bf16(v[j][0], v[j][1]); w.y = pk_bf16(v[j][2], v[j][3]); *(u32x2*)(xb + (size_t)m * DM + 4 * lane + 256 * j) = w; }
        ss = wave_sum(ss);
        if (lane == 0) ssq0[m] = (u64)(ss * SSQ_SCALE);
    }
    convert_items(lds, a, 0, CV_PROLOGUE_END, gw, NGW);
}

DI void conv_pass(const Args& a, int vcu, int G) {
    int tid_ = threadIdx.x; asm volatile("" : "+v"(tid_)); const int tid = tid_;
    const bf16* proj = (const bf16*)(a.ws + WS_PROJ); bf16* XA = (bf16*)(a.ws + WS_XA);
    const float* cwt = a.in[16]; const float* cbs = a.in[17]; const float* stc = a.in[2];
    const int gt = vcu * NTHR + tid, NGT = G * NTHR;
    constexpr int NCG = XBC / 8, RUN = 16, NRUN = NPROMPT / RUN;
    for (int item = gt; item < NRUN * NCG + NSAMP * NCG; item += NGT) {
        const bool samp = item >= NRUN * NCG; const int it2 = samp ? item - NRUN * NCG : item;
        const int cg8 = it2 % NCG, run = it2 / NCG, ch = 8 * cg8;
        float wv[4][8], bs[8];
#pragma unroll
        for (int jj = 0; jj < 4; ++jj) { const f32x4 w0 = *(const f32x4*)(cwt + jj * XBC + ch), w1 = *(const f32x4*)(cwt + jj * XBC + ch + 4);
#pragma unroll
            for (int e = 0; e < 4; ++e) { wv[jj][e] = w0[e]; wv[jj][4 + e] = w1[e]; } }
        { const f32x4 b0 = *(const f32x4*)(cbs + ch), b1 = *(const f32x4*)(cbs + ch + 4);
#pragma unroll
          for (int e = 0; e < 4; ++e) { bs[e] = b0[e]; bs[4 + e] = b1[e]; } }
        if (!samp) {
            const int b = run / (SEQ / RUN), t0 = (run % (SEQ / RUN)) * RUN;
            const bf16* base = proj + ((size_t)b * SEQ) * LDP + PXBC + ch;
            u32x4 rw[RUN + 3];
#pragma unroll
            for (int r = 0; r < RUN + 3; ++r) { const int tt = t0 - 3 + r; rw[r] = (u32x4){0u, 0u, 0u, 0u}; if (tt >= 0) rw[r] = *(const u32x4*)(base + (size_t)tt * LDP); }
#pragma unroll
            for (int r = 0; r < RUN; ++r) { float o[8];
#pragma unroll
                for (int e = 0; e < 8; ++e) { float acc = bs[e];
#pragma unroll
                    for (int jj = 0; jj < 4; ++jj) { const unsigned word = rw[r + jj][e >> 1]; acc += wv[jj][e] * ((e & 1) ? __uint_as_float(word & 0xffff0000u) : __uint_as_float(word << 16)); }
                    o[e] = silu_f(acc); }
                u32x4 ov; ov.x = pk_bf16(o[0], o[1]); ov.y = pk_bf16(o[2], o[3]); ov.z = pk_bf16(o[4], o[5]); ov.w = pk_bf16(o[6], o[7]);
                *(u32x4*)(XA + ((size_t)b * SEQ + t0 + r) * XBC + ch) = ov; }
        } else {
            const int bs_i = run; const float* st = stc + (size_t)bs_i * 3 * XBC + ch; const u32x4 nw = *(const u32x4*)(proj + ((size_t)NPROMPT + bs_i) * LDP + PXBC + ch);
            float o[8];
#pragma unroll
            for (int e = 0; e < 8; ++e) { const unsigned word = nw[e >> 1]; const float xv = (e & 1) ? __uint_as_float(word & 0xffff0000u) : __uint_as_float(word << 16);
                o[e] = silu_f(bs[e] + wv[0][e] * st[e] + wv[1][e] * st[XBC + e] + wv[2][e] * st[2 * XBC + e] + wv[3][e] * xv); }
            u32x4 ov; ov.x = pk_bf16(o[0], o[1]); ov.y = pk_bf16(o[2], o[3]); ov.z = pk_bf16(o[4], o[5]); ov.w = pk_bf16(o[6], o[7]);
            *(u32x4*)(XA + ((size_t)NPROMPT + bs_i) * XBC + ch) = ov;
        }
    }
}

constexpr int ML_CT = 0, ML_KS = 34320, ML_VT = 101904, ML_VTW = 124432, ML_SB = 146960, ML_SBN = 516, ML_SV = 88;
DI float mlstm_scan(float ig0, float ig1, float fg0, float fg1, float ib, float fb, int lane, LAS float* sb, float mst) {
    const float li0 = ig0 + ib, li1 = ig1 + ib, lf0 = log_sigmoid(fg0 + fb), lf1 = log_sigmoid(fg1 + fb);
    float s = lf0 + lf1;
#pragma unroll
    for (int o = 1; o < 64; o <<= 1) { const float tv = __shfl_up(s, o); if (lane >= o) s += tv; }
    const float b1 = s, b0 = s - lf1, g0 = li0 - b0, g1 = li1 - b1;
    float pmx = fmaxf(g0, g1);
#pragma unroll
    for (int o = 1; o < 64; o <<= 1) { const float tv = __shfl_up(pmx, o); if (lane >= o) pmx = fmaxf(pmx, tv); }
    float prev = __shfl_up(pmx, 1); if (lane == 0) prev = -INFINITY;
    const float M0 = fmaxf(mst, fmaxf(prev, g0)), M1 = fmaxf(mst, pmx);
    const float M127 = __shfl(M1, 63), b127 = __shfl(b1, 63);
    *(LAS f32x2*)(sb + 2 * lane) = (f32x2){g0, g1}; *(LAS f32x2*)(sb + 128 + 2 * lane) = (f32x2){b0, b1}; *(LAS f32x2*)(sb + 256 + 2 * lane) = (f32x2){M0, M1};
    *(LAS f32x2*)(sb + 384 + 2 * lane) = (f32x2){__expf(g0 - M127), __expf(g1 - M127)};
    if (lane == 0) { sb[512] = __expf(mst - M127); sb[513] = b127 + M127; sb[514] = mst; }
    return b127 + M127;
}
DI void mlstm_prompt_unit(LAS unsigned char* lds, int unit, const bf16* proj, const float* gsm, const float* i_bias, const float* f_bias,
                          bf16* hml, u64* ssqA, float* pC, float* pn, float* pm, bool atom) {
    int tid_ = threadIdx.x; asm volatile("" : "+v"(tid_)); const int tid = tid_, lane = tid & 63, w = __builtin_amdgcn_readfirstlane(tid >> 6), fr = lane & 15, fq = lane >> 4;
    const int bh = unit >> 3, j = unit & 7, b = bh >> 2, h = bh & 3;
    LAS bf16* CT = (LAS bf16*)(lds + ML_CT); LAS bf16* Ks = (LAS bf16*)(lds + ML_KS); LAS bf16* Vt = (LAS bf16*)(lds + ML_VT); LAS bf16* Vtw = (LAS bf16*)(lds + ML_VTW);
    LAS float* sbuf = (LAS float*)(lds + ML_SB);
    for (int i = tid; i < 65 * 264 / 2; i += NTHR) ((LAS unsigned*)CT)[i] = 0u;
    for (int i = tid; i < 2 * 128 * ML_SV / 2; i += NTHR) ((LAS unsigned*)Vt)[i] = 0u;
    __syncthreads();
    if (tid < 128) Vt[tid * ML_SV + 64] = (bf16)0x3F80u;
    f32x4 Cacc[2][5];
#pragma unroll
    for (int e = 0; e < 2; ++e)
#pragma unroll
        for (int d = 0; d < 5; ++d) Cacc[e][d] = (f32x4){0.f, 0.f, 0.f, 0.f};
    const float ib = i_bias[h], fb = f_bias[h];
    const size_t tokb = (size_t)b * SEQ;
    u32x4 kreg[8], vreg[2]; bf16x8 qnx[8]; float mrun = NEG_INIT;
    const unsigned koff = (unsigned)((tid >> 5) * (LDP * 2) + (tid & 31) * 16), voff = (unsigned)((tid >> 2) * (LDP * 2) + (tid & 3) * 32);
    const unsigned qoff = (unsigned)((16 * w + fr) * (LDP * 2) + fq * 16), goff = (unsigned)lane * 512u, hoff = (unsigned)((16 * w + fr) * (DM * 2) + fq * 8);
    const char* pk0 = (const char*)(proj + tokb * LDP + PK + h * 256); const char* pv0 = (const char*)(proj + tokb * LDP + PV + h * 512 + 64 * j);
    const char* pq0 = (const char*)(proj + tokb * LDP + PQ + h * 256); const char* pg0 = (const char*)(gsm + tokb * 64 + h); char* ph0 = (char*)(hml + tokb * DM + h * 512 + 64 * j);
#define ML_LOAD_KV(c_) do { const size_t cb_ = (size_t)(c_) * 128 * LDP * 2; \
        _Pragma("unroll") for (int i = 0; i < 8; ++i) kreg[i] = *(const u32x4*)(pk0 + cb_ + (size_t)i * 16 * LDP * 2 + koff); \
        _Pragma("unroll") for (int i = 0; i < 2; ++i) vreg[i] = *(const u32x4*)(pv0 + cb_ + 16 * i + voff); \
        _Pragma("unroll") for (int kk = 0; kk < 8; ++kk) qnx[kk] = *(const bf16x8*)(pq0 + cb_ + 64 * kk + qoff); \
        } while (0)
#define ML_LOAD_G(c_) do { { const char* gp_ = pg0 + (size_t)(c_) * 128 * 256 + goff; gz[0] = *(const float*)gp_; gz[1] = *(const float*)(gp_ + 256); gz[2] = *(const float*)(gp_ + 16); gz[3] = *(const float*)(gp_ + 256 + 16); } } while (0)
    ML_LOAD_KV(0);
    if (w == 0) { float gz[4]; ML_LOAD_G(0); mrun = mlstm_scan(gz[0], gz[1], gz[2], gz[3], ib, fb, lane, sbuf, mrun); }
    __syncthreads();
#define LAUNDER(p) asm volatile("" : "+v"(p))
    for (int c = 0; c < 16; ++c) {
        const size_t tok0 = tokb + (size_t)c * 128;
        LAS float* sc = sbuf + (c & 1) * ML_SBN; LAS float* sn = sbuf + ((c + 1) & 1) * ML_SBN;
        const int t = 16 * w + fr;
        LAS bf16* ksw = Ks + (tid >> 5) * 264 + 8 * (tid & 31); LAS bf16* vtw_ = Vt + (tid >> 2) * ML_SV + 16 * (tid & 3);
        const LAS bf16* ksr = Ks + fr * 264 + 8 * fq; const LAS bf16* ctr = CT + fr * 264 + 8 * fq; const LAS bf16* vtr = Vt + (4 * fq + (fr >> 2)) * ML_SV + 4 * (fr & 3); const LAS bf16* vtwr = Vtw + (8 * fq + (fr >> 2)) * ML_SV + 4 * (fr & 3);
        const LAS bf16* kgr = Ks + (8 * fq + (fr >> 2)) * 264 + 32 * w + 4 * (fr & 3); LAS bf16* ctw = CT + (4 * fq) * 264 + 32 * w + fr;
        const LAS float* scq = sc + 4 * fq; const LAS float* sct = sc + t; const LAS float* scs = sc + (tid >> 2);
        LAUNDER(ksw); LAUNDER(vtw_); LAS bf16* vtww = vtw_ + (ML_VTW - ML_VT) / 2; LAUNDER(ksr); LAUNDER(ctr); LAUNDER(vtr); LAUNDER(vtwr); LAUNDER(kgr); LAUNDER(ctw); LAUNDER(scq); LAUNDER(sct); LAUNDER(scs);
        bf16x8 qf[8];
#pragma unroll
        for (int kk = 0; kk < 8; ++kk) qf[kk] = qnx[kk];
#pragma unroll
        for (int i = 0; i < 8; ++i) *(LAS u32x4*)(ksw + i * 16 * 264) = kreg[i];
        {   const float we = scs[384];
#pragma unroll
            for (int i = 0; i < 2; ++i) { u32x4 sw_;
#pragma unroll
                for (int e2 = 0; e2 < 4; ++e2) { const unsigned word = vreg[i][e2]; sw_[e2] = pk_bf16(__uint_as_float(word << 16) * we, __uint_as_float(word & 0xffff0000u) * we); }
                *(LAS u32x4*)(vtw_ + 8 * i) = vreg[i]; *(LAS u32x4*)(vtww + 8 * i) = sw_; }
            if (tid < 128) Vtw[tid * ML_SV + 64] = f2bf(sc[384 + tid]); }
        __syncthreads();
        {
            const float Mt = sct[256], mold = sc[514];
            bf16x8 af[4];
#pragma unroll
            for (int p = 0; p < 4; ++p) { u32x4 pw;
#pragma unroll
                for (int hf = 0; hf < 2; ++hf) { const int sb = 2 * p + hf; f32x4 sa = (f32x4){0.f, 0.f, 0.f, 0.f};
                    if (sb <= w) {
#pragma unroll
                        for (int kk = 0; kk < 8; ++kk) { const bf16x8 kf = *(const LAS bf16x8*)(ksr + (16 * sb) * 264 + 32 * kk); sa = mfma16(kf, qf[kk], sa); } }
                    float v[4]; const f32x4 g4v = *(const LAS f32x4*)(scq + 16 * sb);
#pragma unroll
                    for (int i = 0; i < 4; ++i) { const int s = 16 * sb + 4 * fq + i; v[i] = (sb <= w && s <= t) ? sa[i] * __expf(g4v[i] - Mt) : 0.f; }
                    pw[2 * hf] = pk_bf16(v[0], v[1]); pw[2 * hf + 1] = pk_bf16(v[2], v[3]); }
                af[p] = __builtin_bit_cast(bf16x8, pw);
                __builtin_amdgcn_sched_barrier(0); }
#define ML_NACC(db, dst) do { dst = (f32x4){0.f, 0.f, 0.f, 0.f}; _Pragma("unroll") for (int p = 0; p < 4; ++p) if (2 * p <= w) { const s16x4 lo = lds_tr4(vtr + (32 * p) * ML_SV + 16 * (db)), hi = lds_tr4(vtr + (32 * p + 16) * ML_SV + 16 * (db)); \
                dst = mfma16((bf16x8){lo[0], lo[1], lo[2], lo[3], hi[0], hi[1], hi[2], hi[3]}, af[p], dst); } } while (0)
#define ML_CACC(db, dst) do { dst = (f32x4){0.f, 0.f, 0.f, 0.f}; _Pragma("unroll") for (int kk = 0; kk < 8; ++kk) { const bf16x8 cf = *(const LAS bf16x8*)(ctr + (16 * (db)) * 264 + 32 * kk); dst = mfma16(cf, qf[kk], dst); } } while (0)
            f32x4 n4, c4; ML_NACC(4, n4); ML_CACC(4, c4);
            const float rowsum = __shfl(n4[0], fr), qn = __shfl(c4[0], fr);
            const float winter = __expf(mold - Mt), den = rowsum + winter * qn, mt = sct[128] + Mt;
            const float inv = 1.0f / fmaxf(fabsf(den), __expf(-mt));
            float ss = 0.f;
#pragma unroll
            for (int db = 0; db < 4; ++db) { f32x4 na, ca; ML_NACC(db, na); ML_CACC(db, ca);
                const f32x4 hv = (na + ca * winter) * inv; ss += (hv[0] * hv[0] + hv[1] * hv[1]) + (hv[2] * hv[2] + hv[3] * hv[3]);
                { u32x2 hw_; hw_.x = pk_bf16(hv[0], hv[1]); hw_.y = pk_bf16(hv[2], hv[3]); *(u32x2*)(ph0 + (size_t)c * 128 * DM * 2 + 32 * db + hoff) = hw_; } }
#undef ML_NACC
#undef ML_CACC
            ss += __shfl_xor(ss, 16); ss += __shfl_xor(ss, 32);
            if (fq == 0 && atom) atomicAdd(ssqA + (tok0 + t) * 4 + h, (u64)(ss * SSQ_SCALE));
        }
        if (w == 0 && c < 15) { float gz[4]; ML_LOAD_G(c + 1); mrun = mlstm_scan(gz[0], gz[1], gz[2], gz[3], ib, fb, lane, sn, mrun); }
        __syncthreads();
        {
            if (c < 15) ML_LOAD_KV(c + 1);
            const float decay = sc[512];
#pragma unroll
            for (int e = 0; e < 2; ++e)
#pragma unroll
                for (int d = 0; d < 5; ++d) Cacc[e][d] = Cacc[e][d] * decay;
#pragma unroll
            for (int p = 0; p < 4; ++p) { bf16x8 vtw[5];
#pragma unroll
                for (int db = 0; db < 5; ++db) { const s16x4 v0 = lds_tr4(vtwr + (32 * p) * ML_SV + 16 * db), v1 = lds_tr4(vtwr + (32 * p + 4) * ML_SV + 16 * db); vtw[db] = (bf16x8){v0[0], v0[1], v0[2], v0[3], v1[0], v1[1], v1[2], v1[3]}; }
#pragma unroll
                for (int eb = 0; eb < 2; ++eb) { const s16x4 k0 = lds_tr4(kgr + (32 * p) * 264 + 16 * eb), k1 = lds_tr4(kgr + (32 * p + 4) * 264 + 16 * eb);
                    const bf16x8 kt = (bf16x8){k0[0], k0[1], k0[2], k0[3], k1[0], k1[1], k1[2], k1[3]};
#pragma unroll
                    for (int db = 0; db < 5; ++db) Cacc[eb][db] = mfma16(vtw[db], kt, Cacc[eb][db]); } }
#pragma unroll
            for (int eb = 0; eb < 2; ++eb) {
#pragma unroll
                for (int db = 0; db < 4; ++db)
#pragma unroll
                    for (int i = 0; i < 4; ++i) ctw[(16 * db + i) * 264 + 16 * eb] = f2bf(Cacc[eb][db][i]);
                if (fq == 0) ctw[64 * 264 + 16 * eb] = f2bf(Cacc[eb][4][0]); }
        }
        __syncthreads();
    }
#undef ML_LOAD_KV
#undef ML_LOAD_G
#pragma unroll
    for (int eb = 0; eb < 2; ++eb) {
#pragma unroll
        for (int db = 0; db < 4; ++db) *(f32x4*)(pC + ((size_t)bh * 256 + 32 * w + 16 * eb + fr) * 512 + 64 * j + 16 * db + 4 * fq) = Cacc[eb][db];
        if (j == 0 && fq == 0) pn[bh * 256 + 32 * w + 16 * eb + fr] = Cacc[eb][4][0]; }
    if (j == 0 && tid == 0) pm[bh] = sbuf[ML_SBN + 513];
    __syncthreads();
}

constexpr int SD_BS = 0, SD_CS = 34816, SD_XT = 69632, SD_XTW = 87040, SD_SB = 104448, SD_SC = 121856, SD_SCN = 388;
DI void ssd_scan(float r0, float r1, float dtb, float Aneg, int lane, LAS float* sb) {
    const float dt0 = softplus_f(r0 + dtb), dt1 = softplus_f(r1 + dtb), a0 = dt0 * Aneg, a1 = dt1 * Aneg;
    float s = a0 + a1;
#pragma unroll
    for (int o = 1; o < 64; o <<= 1) { const float tv = __shfl_up(s, o); if (lane >= o) s += tv; }
    const float b1 = s, b0 = s - a1, bl = __shfl(b1, 63);
    *(LAS f32x2*)(sb + 2 * lane) = (f32x2){b0, b1}; *(LAS f32x2*)(sb + 128 + 2 * lane) = (f32x2){dt0, dt1};
    *(LAS f32x2*)(sb + 256 + 2 * lane) = (f32x2){__expf(bl - b0) * dt0, __expf(bl - b1) * dt1};
    if (lane == 0) sb[384] = __expf(bl);
}
DI void ssd_prompt_unit(LAS unsigned char* lds, int unit, const bf16* proj, const bf16* XA, const float* gsm, const float* dt_bias, const float* A_log, const float* Dsk,
                        bf16* ys, u64* ssqB, float* pS, bool atom) {
    int tid_ = threadIdx.x; asm volatile("" : "+v"(tid_)); const int tid = tid_, lane = tid & 63, w = __builtin_amdgcn_readfirstlane(tid >> 6), fr = lane & 15, fq = lane >> 4;
    const int b = unit >> 5, head = unit & 31, g = head >> 4;
    LAS bf16* Bs = (LAS bf16*)(lds + SD_BS); LAS bf16* Cs = (LAS bf16*)(lds + SD_CS); LAS bf16* Xt = (LAS bf16*)(lds + SD_XT); LAS bf16* Xtw = (LAS bf16*)(lds + SD_XTW); LAS bf16* Sb = (LAS bf16*)(lds + SD_SB);
    LAS float* sbuf = (LAS float*)(lds + SD_SC);
    for (int i = tid; i < 64 * 136 / 2; i += NTHR) ((LAS unsigned*)Sb)[i] = 0u;
    f32x4 Sacc[4];
#pragma unroll
    for (int pb = 0; pb < 4; ++pb) Sacc[pb] = (f32x4){0.f, 0.f, 0.f, 0.f};
    const float dtb = dt_bias[head], Aneg = -__expf(A_log[head]), Dk = Dsk[head];
    const size_t tokb = (size_t)b * SEQ;
    u32x4 breg[4], creg[4], xreg[2];
    const unsigned boff = (unsigned)((tid >> 4) * (XBC * 2) + (tid & 15) * 16), xoff = (unsigned)((tid >> 3) * (XBC * 2) + (tid & 7) * 16);
    const unsigned zoff = (unsigned)((16 * w + fr) * (LDP * 2) + fq * 8), goff = (unsigned)lane * 512u, yoff = (unsigned)((16 * w + fr) * (DM * 2) + fq * 8);
    const char* pb0 = (const char*)(XA + tokb * XBC + 2048 + g * 128); const char* px0 = (const char*)(XA + tokb * XBC + head * 64);
    const char* pz0 = (const char*)(proj + tokb * LDP + PZ + head * 64); const char* pg0 = (const char*)(gsm + tokb * 64 + 8 + head); char* py0 = (char*)(ys + tokb * DM + head * 64);
#define SD_LOAD(c_) do { const size_t cb_ = (size_t)(c_) * 128 * XBC * 2; \
        _Pragma("unroll") for (int i = 0; i < 4; ++i) { const char* rp_ = pb0 + cb_ + (size_t)i * 32 * XBC * 2 + boff; breg[i] = *(const u32x4*)rp_; creg[i] = *(const u32x4*)(rp_ + 512); } \
        _Pragma("unroll") for (int i = 0; i < 2; ++i) xreg[i] = *(const u32x4*)(px0 + cb_ + (size_t)i * 64 * XBC * 2 + xoff); \
        } while (0)
#define SD_LOAD_G(c_) do { const char* gp_ = pg0 + (size_t)(c_) * 128 * 256 + goff; gz[0] = *(const float*)gp_; gz[1] = *(const float*)(gp_ + 256); } while (0)
    SD_LOAD(0);
    if (w == 0) { float gz[2]; SD_LOAD_G(0); ssd_scan(gz[0], gz[1], dtb, Aneg, lane, sbuf); }
    __syncthreads();
    for (int c = 0; c < 16; ++c) {
        const size_t tok0 = tokb + (size_t)c * 128;
        LAS float* sc = sbuf + (c & 1) * SD_SCN; LAS float* sn = sbuf + ((c + 1) & 1) * SD_SCN;
        const int t = 16 * w + fr;
        LAS bf16* bsw = Bs + (tid >> 4) * 136 + 8 * (tid & 15); LAS bf16* xtw_ = Xt + (8 * (tid & 7)) * 136 + (tid >> 3);
        const LAS bf16* csr = Cs + t * 136 + 8 * fq; const LAS bf16* bsr = Bs + fr * 136 + 8 * fq; const LAS bf16* xtr = Xt + fr * 136 + 4 * fq; const LAS bf16* sbr = Sb + fr * 136 + 8 * fq;
        const LAS bf16* xtx = Xt + (4 * fq) * 136 + t; const LAS bf16* bgr = Bs + (8 * fq + (fr >> 2)) * 136 + 16 * w + 4 * (fr & 3); const LAS bf16* xtwr = Xtw + fr * 136 + 8 * fq; LAS bf16* sbw = Sb + fr * 136 + 16 * w + 4 * fq;
        const LAS float* scq = sc + 4 * fq; const LAS float* sct = sc + t; const LAS float* scs = sc + (tid >> 3);
        LAUNDER(bsw); LAUNDER(xtw_); LAUNDER(csr); LAUNDER(bsr); LAUNDER(xtr); LAUNDER(sbr); LAUNDER(xtx); LAUNDER(bgr); LAUNDER(xtwr); LAUNDER(sbw); LAUNDER(scq); LAUNDER(sct); LAUNDER(scs);
#pragma unroll
        for (int i = 0; i < 4; ++i) { *(LAS u32x4*)(bsw + i * 32 * 136) = breg[i]; *(LAS u32x4*)(bsw + (SD_CS - SD_BS) / 2 + i * 32 * 136) = creg[i]; }
#pragma unroll
        for (int i = 0; i < 2; ++i) { const float we = scs[256 + 64 * i];
#pragma unroll
            for (int e = 0; e < 8; ++e) { const unsigned word = xreg[i][e >> 1]; const unsigned raw = (e & 1) ? (word >> 16) : (word & 0xffffu);
                xtw_[e * 136 + 64 * i] = (bf16)raw; xtw_[(SD_XTW - SD_XT) / 2 + e * 136 + 64 * i] = f2bf(bf2f(raw) * we); } }
        const char* zp_ = pz0 + (size_t)c * 128 * LDP * 2 + zoff;
        const u32x2 zr0 = *(const u32x2*)zp_, zr1 = *(const u32x2*)(zp_ + 32), zr2 = *(const u32x2*)(zp_ + 64), zr3 = *(const u32x2*)(zp_ + 96);
        __syncthreads();
        {
            const float bt = sct[0];
            bf16x8 cf[4];
#pragma unroll
            for (int kk = 0; kk < 4; ++kk) cf[kk] = *(const LAS bf16x8*)(csr + 32 * kk);
            bf16x8 af[4];
#pragma unroll
            for (int p = 0; p < 4; ++p) { u32x4 pw;
#pragma unroll
                for (int hf = 0; hf < 2; ++hf) { const int sb = 2 * p + hf; f32x4 sa = (f32x4){0.f, 0.f, 0.f, 0.f};
                    if (sb <= w) {
#pragma unroll
                        for (int kk = 0; kk < 4; ++kk) { const bf16x8 bfg = *(const LAS bf16x8*)(bsr + (16 * sb) * 136 + 32 * kk); sa = mfma16(bfg, cf[kk], sa); } }
                    float v[4]; const f32x4 b4 = *(const LAS f32x4*)(scq + 16 * sb), d4 = *(const LAS f32x4*)(scq + 128 + 16 * sb);
#pragma unroll
                    for (int i = 0; i < 4; ++i) { const int s = 16 * sb + 4 * fq + i; v[i] = (sb <= w && s <= t) ? sa[i] * __expf(bt - b4[i]) * d4[i] : 0.f; }
                    pw[2 * hf] = pk_bf16(v[0], v[1]); pw[2 * hf + 1] = pk_bf16(v[2], v[3]); }
                af[p] = __builtin_bit_cast(bf16x8, pw); }
            const float ebt = __expf(bt);
            float ss = 0.f;
#pragma unroll
            for (int pb = 0; pb < 4; ++pb) { f32x4 yacc = (f32x4){0.f, 0.f, 0.f, 0.f}, y2 = yacc;
#pragma unroll
                for (int p = 0; p < 4; ++p) if (2 * p <= w) { const LAS bf16* xp = xtr + (16 * pb) * 136 + 32 * p;
                    const u32x2 lo = *(const LAS u32x2*)xp, hi = *(const LAS u32x2*)(xp + 16); u32x4 vv; vv.x = lo.x; vv.y = lo.y; vv.z = hi.x; vv.w = hi.y;
                    yacc = mfma16(__builtin_bit_cast(bf16x8, vv), af[p], yacc); }
#pragma unroll
                for (int kk = 0; kk < 4; ++kk) { const bf16x8 sf = *(const LAS bf16x8*)(sbr + (16 * pb) * 136 + 32 * kk); y2 = mfma16(sf, cf[kk], y2); }
                const u32x2 zr = pb == 0 ? zr0 : (pb == 1 ? zr1 : (pb == 2 ? zr2 : zr3));
                f32x4 o;
#pragma unroll
                for (int i = 0; i < 4; ++i) { const float xv = bf2f(xtx[(16 * pb + i) * 136]); const unsigned zw = zr[i >> 1]; const float z = (i & 1) ? __uint_as_float(zw & 0xffff0000u) : __uint_as_float(zw << 16);
                    const float y = yacc[i] + ebt * y2[i] + Dk * xv; o[i] = y * silu_f(z); ss += o[i] * o[i]; }
                { u32x2 ow_; ow_.x = pk_bf16(o[0], o[1]); ow_.y = pk_bf16(o[2], o[3]); *(u32x2*)(py0 + (size_t)c * 128 * DM * 2 + 32 * pb + yoff) = ow_; } }
            ss += __shfl_xor(ss, 16); ss += __shfl_xor(ss, 32);
            if (fq == 0 && atom) atomicAdd(ssqB + (tok0 + t) * 2 + g, (u64)(ss * SSQ_SCALE));
        }
        if (w == 0 && c < 15) { float gz[2]; SD_LOAD_G(c + 1); ssd_scan(gz[0], gz[1], dtb, Aneg, lane, sn); }
        __syncthreads();
        {
            if (c < 15) SD_LOAD(c + 1);
            const float eb = sc[384];
#pragma unroll
            for (int pb = 0; pb < 4; ++pb) Sacc[pb] = Sacc[pb] * eb;
#pragma unroll
            for (int p = 0; p < 4; ++p) { const s16x4 b0 = lds_tr4(bgr + (32 * p) * 136), b1 = lds_tr4(bgr + (32 * p + 4) * 136);
                const bf16x8 btf = (bf16x8){b0[0], b0[1], b0[2], b0[3], b1[0], b1[1], b1[2], b1[3]};
#pragma unroll
                for (int pb = 0; pb < 4; ++pb) { const bf16x8 xf = *(const LAS bf16x8*)(xtwr + (16 * pb) * 136 + 32 * p); Sacc[pb] = mfma16(btf, xf, Sacc[pb]); } }
#pragma unroll
            for (int pb = 0; pb < 4; ++pb) { u32x2 o; o.x = pk_bf16(Sacc[pb][0], Sacc[pb][1]); o.y = pk_bf16(Sacc[pb][2], Sacc[pb][3]); *(LAS u32x2*)(sbw + (16 * pb) * 136) = o; }
        }
        __syncthreads();
    }
#undef SD_LOAD
#undef SD_LOAD_G
#pragma unroll
    for (int pb = 0; pb < 4; ++pb) *(f32x4*)(pS + (((size_t)b * 32 + head) * 64 + 16 * pb + fr) * 128 + 16 * w + 4 * fq) = Sacc[pb];
    __syncthreads();
}

DI void mlstm_decode_unit(LAS unsigned char* lds, int unit, const bf16* proj, const float* gsm, const float* i_bias, const float* f_bias,
                          const float* stC, const float* stn, const float* stm, bf16* hml, u64* ssqA, float* sC, float* sn, float* sm, bool atom) {
    int tid_ = threadIdx.x; asm volatile("" : "+v"(tid_)); const int tid = tid_, lane = tid & 63, w = __builtin_amdgcn_readfirstlane(tid >> 6);
    const int bs = unit >> 2, h = unit & 3; const size_t R = (size_t)NPROMPT + bs;
    LAS float* qs = (LAS float*)lds; LAS float* ks = qs + 256; LAS float* vs = ks + 256; LAS float* ns = vs + 512; LAS float* red = ns + 256; LAS f32x4* red4 = (LAS f32x4*)(red + 64);
    if (tid < 256) { qs[tid] = bf2f(proj[R * LDP + PQ + h * 256 + tid]); ks[tid] = bf2f(proj[R * LDP + PK + h * 256 + tid]); ns[tid] = stn[(size_t)unit * 256 + tid]; }
    vs[tid] = bf2f(proj[R * LDP + PV + h * 512 + tid]);
    __syncthreads();
    { float pqk = 0.f, pqn = 0.f; if (tid < 256) { pqk = qs[tid] * ks[tid]; pqn = qs[tid] * ns[tid]; }
      pqk = wave_sum(pqk); pqn = wave_sum(pqn); if (lane == 0) { red[w] = pqk; red[8 + w] = pqn; } }
    __syncthreads();
    const float qk = (red[0] + red[1]) + (red[2] + red[3]), qn = (red[8] + red[9]) + (red[10] + red[11]);
    const float li = gsm[R * 64 + h] + i_bias[h], lf = log_sigmoid(gsm[R * 64 + 4 + h] + f_bias[h]), m0 = stm[unit];
    const float mt = fmaxf(lf + m0, li), wi = __expf(li - mt), wo = __expf(lf + m0 - mt);
    const float sv = qk * wi, den = sv + wo * qn, inv = 1.0f / fmaxf(fabsf(den), __expf(-mt));
    const int col4 = tid & 127, dg = tid >> 7;
    const f32x4* Cin = (const f32x4*)(stC + (size_t)unit * 131072); f32x4* Cout = (f32x4*)(sC + (size_t)unit * 131072);
    const f32x4 v4 = *(const LAS f32x4*)(vs + 4 * col4);
    f32x4 acc = (f32x4){0.f, 0.f, 0.f, 0.f};
#pragma unroll 1
    for (int it = 0; it < 64; it += 8) { f32x4 cv[8];
#pragma unroll
        for (int u = 0; u < 8; ++u) cv[u] = __builtin_nontemporal_load(Cin + (size_t)(4 * (it + u) + dg) * 128 + col4);
#pragma unroll
        for (int u = 0; u < 8; ++u) { const int d = 4 * (it + u) + dg; const float qd = qs[d], kd = ks[d] * wi; acc += cv[u] * qd;
            __builtin_nontemporal_store(cv[u] * wo + v4 * kd, Cout + (size_t)d * 128 + col4); } }
    red4[dg * 128 + col4] = acc;
    __syncthreads();
    float ss = 0.f;
    if (dg == 0) { const f32x4 tot = (red4[col4] + red4[128 + col4]) + (red4[256 + col4] + red4[384 + col4]);
        const f32x4 hv = (v4 * sv + tot * wo) * inv; ss = (hv[0] * hv[0] + hv[1] * hv[1]) + (hv[2] * hv[2] + hv[3] * hv[3]);
        { u32x2 hw_; hw_.x = pk_bf16(hv[0], hv[1]); hw_.y = pk_bf16(hv[2], hv[3]); *(u32x2*)(hml + R * DM + h * 512 + 4 * col4) = hw_; } }
    ss = wave_sum(ss);
    if (lane == 0 && w < 2 && atom) atomicAdd(ssqA + R * 4 + h, (u64)(ss * SSQ_SCALE));
    if (tid < 256) sn[(size_t)unit * 256 + tid] = wo * ns[tid] + wi * ks[tid];
    if (tid == 0) sm[unit] = mt;
    __syncthreads();
}
DI void ssd_decode_unit(LAS unsigned char* lds, int unit, const bf16* proj, const bf16* XA, const float* gsm, const float* dt_bias, const float* A_log, const float* Dsk,
                        const float* stS, bf16* ys, u64* ssqB, float* sS, bool atom) {
    int tid_ = threadIdx.x; asm volatile("" : "+v"(tid_)); const int tid = tid_, lane = tid & 63, w = __builtin_amdgcn_readfirstlane(tid >> 6);
    const int bs = unit >> 2, head = 8 * (unit & 3) + w, g = head >> 4; const size_t R = (size_t)NPROMPT + bs;
    LAS float* xs = (LAS float*)(lds + w * 2048); LAS float* Bv = xs + 64; LAS float* Cv = Bv + 128;
    const bf16* xr = XA + R * XBC;
    xs[lane] = bf2f(xr[head * 64 + lane]);
    Bv[lane] = bf2f(xr[2048 + g * 128 + lane]); Bv[lane + 64] = bf2f(xr[2048 + g * 128 + 64 + lane]);
    Cv[lane] = bf2f(xr[2304 + g * 128 + lane]); Cv[lane + 64] = bf2f(xr[2304 + g * 128 + 64 + lane]);
    asm volatile("s_waitcnt lgkmcnt(0)" ::: "memory");
    const float cbdot = wave_sum(Cv[lane] * Bv[lane] + Cv[lane + 64] * Bv[lane + 64]);
    const float dt = softplus_f(gsm[R * 64 + 8 + head] + dt_bias[head]), ea = __expf(-dt * __expf(A_log[head])), Dk = Dsk[head];
    const int n4 = lane & 31, prow = lane >> 5;
    const f32x4 B4 = *(const LAS f32x4*)(Bv + 4 * n4), C4 = *(const LAS f32x4*)(Cv + 4 * n4);
    const f32x4* Sin = (const f32x4*)(stS + ((size_t)bs * 32 + head) * 8192); f32x4* Sout = (f32x4*)(sS + ((size_t)bs * 32 + head) * 8192);
    float ss = 0.f;
#pragma unroll 1
    for (int it = 0; it < 32; it += 8) { f32x4 sv[8];
#pragma unroll
        for (int u = 0; u < 8; ++u) sv[u] = __builtin_nontemporal_load(Sin + (size_t)(2 * (it + u) + prow) * 32 + n4);
#pragma unroll
        for (int u = 0; u < 8; ++u) { const int p = 2 * (it + u) + prow; const float xp = xs[p];
            __builtin_nontemporal_store(sv[u] * ea + B4 * (dt * xp), Sout + (size_t)p * 32 + n4);
            float y2 = (C4[0] * sv[u][0] + C4[1] * sv[u][1]) + (C4[2] * sv[u][2] + C4[3] * sv[u][3]);
#pragma unroll
            for (int o = 1; o < 32; o <<= 1) y2 += __shfl_xor(y2, o);
            const float z = bf2f(proj[R * LDP + PZ + head * 64 + p]);
            const float yv = (cbdot * dt * xp + ea * y2 + Dk * xp) * silu_f(z);
            if (n4 == 0) { ys[R * DM + head * 64 + p] = f2bf(yv); ss += yv * yv; } } }
    ss += __shfl_xor(ss, 32);
    if (lane == 0 && atom) atomicAdd(ssqB + R * 2 + g, (u64)(ss * SSQ_SCALE));
}

DI void merge_phase(const Args& a, int vcu, int G) {
    int tid_ = threadIdx.x; asm volatile("" : "+v"(tid_)); const int tid = tid_, lane = tid & 63, wave = __builtin_amdgcn_readfirstlane(tid >> 6);
    unsigned char* ws = a.ws;
    const bf16* proj = (const bf16*)(ws + WS_PROJ); const bf16* hml = (const bf16*)(ws + WS_HML); const bf16* ys = (const bf16*)(ws + WS_YS);
    const u64* ssqA = (const u64*)(ws + WS_SSQ) + SSQA; const u64* ssqB = (const u64*)(ws + WS_SSQ) + SSQB;
    bf16* mg = (bf16*)(ws + WS_MERGED); const float* hnw = a.in[15]; const float* snw = a.in[21];
    const int gw = vcu * NWAVES + wave, NGW = G * NWAVES;
    for (int row = gw; row < NTOK; row += NGW) {
        float rA[4], rB[2];
#pragma unroll
        for (int i = 0; i < 4; ++i) rA[i] = rs_from(ssqA, row * 4 + i, 1.0f / 512.0f);
#pragma unroll
        for (int i = 0; i < 2; ++i) rB[i] = rs_from(ssqB, row * 2 + i, 1.0f / 1024.0f);
#pragma unroll
        for (int it = 0; it < 8; ++it) { const int c = 4 * lane + 256 * it;
            const u32x2 hr = *(const u32x2*)(hml + (size_t)row * DM + c), yr = *(const u32x2*)(ys + (size_t)row * DM + c); const f32x4 hw = *(const f32x4*)(hnw + c), sw = *(const f32x4*)(snw + c);
            const f32x4 hv = (f32x4){__uint_as_float(hr.x << 16), __uint_as_float(hr.x & 0xffff0000u), __uint_as_float(hr.y << 16), __uint_as_float(hr.y & 0xffff0000u)}, yv = (f32x4){__uint_as_float(yr.x << 16), __uint_as_float(yr.x & 0xffff0000u), __uint_as_float(yr.y << 16), __uint_as_float(yr.y & 0xffff0000u)};
            const u32x2 og = *(const u32x2*)(proj + (size_t)row * LDP + POG + c), ga = *(const u32x2*)(proj + (size_t)row * LDP + PGATE + c), gb = *(const u32x2*)(proj + (size_t)row * LDP + PGATE + DM + c);
            float o[4];
#pragma unroll
            for (int i = 0; i < 4; ++i) { const unsigned ow = og[i >> 1], aw = ga[i >> 1], bw = gb[i >> 1];
                const float ogf = (i & 1) ? __uint_as_float(ow & 0xffff0000u) : __uint_as_float(ow << 16), gaf = (i & 1) ? __uint_as_float(aw & 0xffff0000u) : __uint_as_float(aw << 16), gbf = (i & 1) ? __uint_as_float(bw & 0xffff0000u) : __uint_as_float(bw << 16);
                o[i] = sigm_f(gaf) * (sigm_f(ogf) * hv[i] * rA[it >> 1] * hw[i]) + sigm_f(gbf) * (yv[i] * rB[it >> 2] * sw[i]); }
            u32x2 wv; wv.x = pk_bf16(o[0], o[1]); wv.y = pk_bf16(o[2], o[3]); *(u32x2*)(mg + (size_t)row * DM + c) = wv; }
    }
    float* out = a.out; const int gt = vcu * NTHR + tid, NGT = G * NTHR;
    for (int i = gt; i < NBATCH * 3 * XBC; i += NGT) { const int ch = i % XBC, r = (i / XBC) % 3, b = i / (3 * XBC); out[O_PCONV + i] = bf2f(proj[((size_t)b * SEQ + SEQ - 3 + r) * LDP + PXBC + ch]); }
    const float* stc = a.in[2];
    for (int i = gt; i < NSAMP * 3 * XBC; i += NGT) { const int ch = i % XBC, r = (i / XBC) % 3, bs = i / (3 * XBC);
        out[O_SCONV + i] = r < 2 ? stc[(size_t)bs * 3 * XBC + (r + 1) * XBC + ch] : bf2f(proj[((size_t)NPROMPT + bs) * LDP + PXBC + ch]); }
}
DI void final_norm_phase(const Args& a, int vcu, int G) {
    int tid_ = threadIdx.x; asm volatile("" : "+v"(tid_)); const int tid = tid_, lane = tid & 63, wave = __builtin_amdgcn_readfirstlane(tid >> 6);
    const u64* ssq3 = (const u64*)(a.ws + WS_SSQ) + SSQ3; const float* fw = a.in[27]; float* out = a.out; const bf16* xb = (const bf16*)(a.ws + WS_XB);
    const int gw = vcu * NWAVES + wave, NGW = G * NWAVES;
    for (int row = gw; row < NTOK; row += NGW) { const float r = rs_from(ssq3, row, 1.0f / 2048.0f);
#pragma unroll
        for (int it = 0; it < 4; ++it) { const int c = 8 * lane + 512 * it; const u32x4 xr = *(const u32x4*)(xb + (size_t)row * DM + c);
            const f32x4 f0 = *(const f32x4*)(fw + c), f1 = *(const f32x4*)(fw + c + 4);
            const f32x4 v0 = (f32x4){__uint_as_float(xr.x << 16), __uint_as_float(xr.x & 0xffff0000u), __uint_as_float(xr.y << 16), __uint_as_float(xr.y & 0xffff0000u)};
            const f32x4 v1 = (f32x4){__uint_as_float(xr.z << 16), __uint_as_float(xr.z & 0xffff0000u), __uint_as_float(xr.w << 16), __uint_as_float(xr.w & 0xffff0000u)};
            *(f32x4*)(out + (size_t)row * DM + c) = v0 * r * f0; *(f32x4*)(out + (size_t)row * DM + c + 4) = v1 * r * f1; } }
}

template <int KSTEPS>
DI void gemm_skinny(LAS unsigned char* lds, int c, const bf16* A, const bf16* Bt, const float* res, const bf16* resb, float alpha, float* out, bf16* xb, u64* ssq) {
    int tid_ = threadIdx.x; asm volatile("" : "+v"(tid_)); const int tid = tid_, lane = tid & 63, w = __builtin_amdgcn_readfirstlane(tid >> 6), fr = lane & 15, fq = lane >> 4;
    constexpr int K = KSTEPS * 256, kw = K / 8;
    const int cb = c >> 1, r0 = 64 * (c & 1);
    const bf16* ap = A + (size_t)(NPROMPT + r0 + fr) * K + w * kw + 8 * fq;
    const bf16* bp = Bt + (size_t)(16 * cb + fr) * K + w * kw + 8 * fq;
    f32x4 acc[4];
#pragma unroll
    for (int rb = 0; rb < 4; ++rb) acc[rb] = (f32x4){0.f, 0.f, 0.f, 0.f};
#pragma unroll
    for (int k0 = 0; k0 < KSTEPS; k0 += 4) { bf16x8 bfg[4], af[4][4];
#pragma unroll
        for (int u = 0; u < 4; ++u) if (k0 + u < KSTEPS) { bfg[u] = *(const bf16x8*)(bp + 32 * (k0 + u));
#pragma unroll
            for (int rb = 0; rb < 4; ++rb) af[u][rb] = *(const bf16x8*)(ap + (size_t)rb * 16 * K + 32 * (k0 + u)); }
#pragma unroll
        for (int u = 0; u < 4; ++u) if (k0 + u < KSTEPS) {
#pragma unroll
            for (int rb = 0; rb < 4; ++rb) acc[rb] = mfma16(bfg[u], af[u][rb], acc[rb]); } }
    LAS f32x4* red = (LAS f32x4*)lds;
#pragma unroll
    for (int rb = 0; rb < 4; ++rb) red[(w * 4 + rb) * 64 + lane] = acc[rb];
    __syncthreads();
    if (w < 4) {
        f32x4 sum = red[w * 64 + lane];
#pragma unroll
        for (int w2 = 1; w2 < 8; ++w2) sum += red[(w2 * 4 + w) * 64 + lane];
        const int rl = r0 + 16 * w + fr, col = 16 * cb + 4 * fq;
        f32x4 rv;
        if (res) rv = *(const f32x4*)(res + (size_t)rl * DM + col);
        else { const u32x2 rw = *(const u32x2*)(resb + (size_t)(NPROMPT + rl) * DM + col); rv = (f32x4){__uint_as_float(rw.x << 16), __uint_as_float(rw.x & 0xffff0000u), __uint_as_float(rw.y << 16), __uint_as_float(rw.y & 0xffff0000u)}; }
        const f32x4 o = rv + sum * alpha;
        if (out) *(f32x4*)(out + (size_t)rl * DM + col) = o;
        if (xb) { u32x2 wv; wv.x = pk_bf16(o[0], o[1]); wv.y = pk_bf16(o[2], o[3]); *(u32x2*)(xb + (size_t)(NPROMPT + rl) * DM + col) = wv; }
        float ss = (o[0] * o[0] + o[1] * o[1]) + (o[2] * o[2] + o[3] * o[3]);
        ss += __shfl_xor(ss, 16); ss += __shfl_xor(ss, 32);
        if (fq == 0) atomicAdd(ssq + NPROMPT + rl, (u64)(ss * SSQ_SCALE));
    }
    __syncthreads();
}

#define XB_TMO      128
#define XB_XCNT(j)  (256  + 64 * (j))
#define XB_XSUB(j)  (1280 + 64 * (j))
#define XB_XGEN(j)  (2304 + 64 * (j))
#define XB_TOP      3328
#define XB_TOPGEN   3392
#define XCD_BAR_WORDS 3456
#define XB_SPIN_CAP (1u << 18)

__device__ __forceinline__ unsigned xb_ld(unsigned* p)              { return __hip_atomic_load(p, __ATOMIC_RELAXED, __HIP_MEMORY_SCOPE_AGENT); }
__device__ __forceinline__ unsigned xb_add(unsigned* p, unsigned v) { return __hip_atomic_fetch_add(p, v, __ATOMIC_RELAXED, __HIP_MEMORY_SCOPE_AGENT); }
__device__ __forceinline__ unsigned xb_xcc_id() { return (unsigned)__builtin_amdgcn_s_getreg((3 << 11) | 20) & 0xFu; }
#define XB_SPIN(cond, bar) do { unsigned _sp = 0; while (cond) { __builtin_amdgcn_s_sleep(1); \
    if ((++_sp & 255u) == 0u) { if (xb_ld(&(bar)[XB_TMO])) break; if (_sp > XB_SPIN_CAP) { atomicAdd(&(bar)[XB_TMO], 1u); break; } } } } while (0)

struct XcdBarrier {
    unsigned* bar; unsigned x;
    volatile LAS unsigned* st;
};

__device__ __forceinline__ XcdBarrier xcd_barrier_post(unsigned* bar, volatile LAS unsigned* st) {
    XcdBarrier b; b.bar = bar; b.x = xb_xcc_id(); b.st = st;
    if (threadIdx.x == 0) (void)xb_add(&bar[XB_XCNT(b.x)], 1u);
    return b;
}
__device__ __forceinline__ void xcd_barrier_complete(unsigned* bar, unsigned x, unsigned& nloc, unsigned& nx) {
    const unsigned G = gridDim.x * gridDim.y * gridDim.z;
    unsigned sum, cnt, mine, sp = 0u;
    for (;;) {
        sum = 0u; cnt = 0u; mine = 0u;
#pragma unroll
        for (unsigned j = 0; j < 16; ++j) { const unsigned c = xb_ld(&bar[XB_XCNT(j)]); sum += c; cnt += (c > 0u) ? 1u : 0u; mine = (j == x) ? c : mine; }
        if (sum == G) break;
        __builtin_amdgcn_s_sleep(1);
        if ((++sp & 255u) == 0u) { if (xb_ld(&bar[XB_TMO])) break; if (sp > XB_SPIN_CAP) { atomicAdd(&bar[XB_TMO], 1u); break; } }
    }
    nloc = mine > 0u ? mine : 1u; nx = cnt > 0u ? cnt : 1u;
}

__device__ __forceinline__ void xcd_barrier(const XcdBarrier& b) {
    asm volatile("s_waitcnt vmcnt(0)" ::: "memory");
    __syncthreads();
    if (threadIdx.x == 0) {
        unsigned* bar = b.bar;
        __builtin_amdgcn_s_waitcnt(0);
        unsigned nloc = b.st[0], nx = b.st[1];
        if (nloc == 0u) { xcd_barrier_complete(bar, b.x, nloc, nx); b.st[0] = nloc; b.st[1] = nx; }
        const unsigned old = xb_add(&bar[XB_XSUB(b.x)], 1u);
        const unsigned gen = old / nloc;
        if (old + 1u == (gen + 1u) * nloc) {
            __builtin_amdgcn_fence(__ATOMIC_RELEASE, "agent");
            asm volatile("s_waitcnt vmcnt(0)" ::: "memory");
            const unsigned og = xb_add(&bar[XB_TOP], 1u);
            const unsigned tg = og / nx;
            if (og + 1u == (tg + 1u) * nx) xb_add(&bar[XB_TOPGEN], 1u);
            else XB_SPIN(xb_ld(&bar[XB_TOPGEN]) == tg, bar);
            __builtin_amdgcn_fence(__ATOMIC_ACQUIRE, "agent");
            xb_add(&bar[XB_XGEN(b.x)], 1u);
            asm volatile("s_waitcnt vmcnt(0)" ::: "memory");
        } else {
            XB_SPIN(xb_ld(&bar[XB_XGEN(b.x)]) == gen, bar);
            __builtin_amdgcn_fence(__ATOMIC_ACQUIRE, "agent");
            asm volatile("s_waitcnt vmcnt(0)" ::: "memory");
        }
    }
    __syncthreads();
}


__global__ void __launch_bounds__(NTHR, 2) hybrid_fwd(Args a) {
    extern __shared__ __attribute__((aligned(16))) unsigned char lds_raw[];
    LAS unsigned char* lds = (LAS unsigned char*)lds_raw;
    cg::grid_group grid = cg::this_grid();
    const int G = gridDim.x, bx = blockIdx.x;
    const int vcu = (G % 8 == 0) ? (bx % 8) * (G / 8) + bx / 8 : bx;
    unsigned char* ws = a.ws;
    volatile LAS unsigned* bst = (volatile LAS unsigned*)(lds + LDS_BYTES - 16);
    if (threadIdx.x < 4) bst[threadIdx.x] = 0u;
    __syncthreads();
    XcdBarrier xbar = xcd_barrier_post((unsigned*)(ws + WS_BAR), bst);
    u64* ssq = (u64*)(ws + WS_SSQ);
    bf16* xb = (bf16*)(ws + WS_XB); bf16* Hb = (bf16*)(ws + WS_H); bf16* proj = (bf16*)(ws + WS_PROJ); bf16* mg = (bf16*)(ws + WS_MERGED);
    float* gsm = (float*)(ws + WS_GSM); bf16* hml = (bf16*)(ws + WS_HML); bf16* ysb = (bf16*)(ws + WS_YS);

    if (a.out == nullptr) grid.sync();
    p0_prologue(lds, a, vcu, G);
    xcd_barrier(xbar);
    {
        pg8::Gemm g{xb, (const bf16*)(ws + WS_WGU1), MP, NGU, DM}; pg8::StaticOrder S; S.init(MP, NGU, G, bx);
        pg8::EpiSwiGLU E{Hb, FF, ssq + SSQ0};
        pg8::gemm_phase<pg8::EpiSwiGLU, pg8::StaticOrder, true, true>(lds, g, S, E);
        { const int nfull = (MP / 256) * (NGU / 256) % G;
          if (nfull && bx >= nfull) convert_items(lds, a, CV_PROLOGUE_END, CV_G1TAIL_END, (bx - nfull) * NWAVES + __builtin_amdgcn_readfirstlane((int)(threadIdx.x >> 6)), (G - nfull) * NWAVES); }
    }
    xcd_barrier(xbar);
    {
        pg8::Gemm g{Hb, (const bf16*)(ws + WS_WD1), NPROMPT, DM, FF}; pg8::StaticOrder S; S.init(NPROMPT, DM, G, bx);
        pg8::EpiResid E{nullptr, xb, nullptr, xb, ssq + SSQ1, 0.5f};
        pg8::gemm_phase<pg8::EpiResid, pg8::StaticOrder, true, true>(lds, g, S, E);
        for (int c = vcu; c < 256; c += G) gemm_skinny<FF / 256>(lds, c, Hb, (const bf16*)(ws + WS_WD1), nullptr, xb, 0.5f, nullptr, xb, ssq + SSQ1);
    }
    xcd_barrier(xbar);
    {
        pg8::Gemm g{xb, (const bf16*)(ws + WS_WIN), MP, NPROJ, DM}; pg8::StaticOrder S; S.init(MP, NPROJ, G, bx);
        pg8::EpiProj E{proj, LDP, gsm, ssq + SSQ1, LDP / 256};
        pg8::gemm_phase<pg8::EpiProj, pg8::StaticOrder, true, true>(lds, g, S, E);
        { const int nfull = (MP / 256) * (NPROJ / 256) % G;
          if (nfull && bx >= nfull) convert_items(lds, a, CV_G1TAIL_END, CV_END, (bx - nfull) * NWAVES + __builtin_amdgcn_readfirstlane((int)(threadIdx.x >> 6)), (G - nfull) * NWAVES); }
    }
    xcd_barrier(xbar);
    {
        float* out = a.out; const bf16* XA = (const bf16*)(ws + WS_XA);
        unsigned* qctr = (unsigned*)(ws + WS_BAR) + XCD_BAR_WORDS;
        const bool split = (G == 256);
        bool conv_seen = !split;
        if (!split) { conv_pass(a, vcu, G); xcd_barrier(xbar); }
        else if (vcu >= 128) {
            conv_pass(a, vcu - 128, 128);
            asm volatile("s_waitcnt vmcnt(0)" ::: "memory"); __syncthreads();
            if (threadIdx.x == 0) { __builtin_amdgcn_fence(__ATOMIC_RELEASE, "agent"); asm volatile("s_waitcnt vmcnt(0)" ::: "memory");
                __hip_atomic_fetch_add(qctr + 32, 1u, __ATOMIC_RELAXED, __HIP_MEMORY_SCOPE_AGENT); }
        }
#define WAIT_CONV() do { if (!conv_seen) { if (threadIdx.x == 0) { unsigned sp_ = 0u; \
            while (__hip_atomic_load(qctr + 32, __ATOMIC_RELAXED, __HIP_MEMORY_SCOPE_AGENT) < 128u) { __builtin_amdgcn_s_sleep(2); if (++sp_ > (1u << 22)) break; } \
            __builtin_amdgcn_fence(__ATOMIC_ACQUIRE, "agent"); asm volatile("s_waitcnt vmcnt(0)" ::: "memory"); } \
            __syncthreads(); conv_seen = true; } } while (0)
        for (int u = vcu; u < 256; u += G) {
            if (u < 128) mlstm_prompt_unit(lds, u, proj, gsm, a.in[13], a.in[14], hml, ssq + SSQA, out + O_PC, out + O_PN, out + O_PM, true);
            else { WAIT_CONV(); ssd_prompt_unit(lds, u - 128, proj, XA, gsm, a.in[18], a.in[19], a.in[20], ysb, ssq + SSQB, out + O_PSSM, true); } }
        for (;;) {
            if (threadIdx.x == 0) bst[2] = atomicAdd(qctr, 1u);
            __syncthreads();
            const int u = (int)bst[2];
            __syncthreads();
            if (u >= 1024) break;
            if (u < 512) mlstm_decode_unit(lds, u, proj, gsm, a.in[13], a.in[14], a.in[3], a.in[4], a.in[5], hml, ssq + SSQA, out + O_SC, out + O_SN, out + O_SM, true);
            else { WAIT_CONV(); ssd_decode_unit(lds, u - 512, proj, XA, gsm, a.in[18], a.in[19], a.in[20], a.in[6], ysb, ssq + SSQB, out + O_SSSM, true); }
        }
#undef WAIT_CONV
    }
    xcd_barrier(xbar);
    merge_phase(a, vcu, G);
    xcd_barrier(xbar);
    {
        pg8::Gemm g{mg, (const bf16*)(ws + WS_WOUT), NPROMPT, DM, DM}; pg8::StaticOrder S; S.init(NPROMPT, DM, G, bx);
        pg8::EpiResid E{nullptr, xb, nullptr, xb, ssq + SSQ2, 1.0f};
        pg8::gemm_phase<pg8::EpiResid, pg8::StaticOrder, true, true>(lds, g, S, E);
        for (int c = vcu; c < 256; c += G) gemm_skinny<DM / 256>(lds, c, mg, (const bf16*)(ws + WS_WOUT), nullptr, xb, 1.0f, nullptr, xb, ssq + SSQ2);
    }
    xcd_barrier(xbar);
    {
        pg8::Gemm g{xb, (const bf16*)(ws + WS_WGU2), MP, NGU, DM}; pg8::StaticOrder S; S.init(MP, NGU, G, bx);
        pg8::EpiSwiGLU E{Hb, FF, ssq + SSQ2};
        pg8::gemm_phase<pg8::EpiSwiGLU, pg8::StaticOrder, true, true>(lds, g, S, E);
    }
    xcd_barrier(xbar);
    {
        pg8::Gemm g{Hb, (const bf16*)(ws + WS_WD2), NPROMPT, DM, FF}; pg8::StaticOrder S; S.init(NPROMPT, DM, G, bx);
        pg8::EpiResid E{nullptr, xb, nullptr, xb, ssq + SSQ3, 0.5f};
        pg8::gemm_phase<pg8::EpiResid, pg8::StaticOrder, true, true>(lds, g, S, E);
        for (int c = vcu; c < 256; c += G) gemm_skinny<FF / 256>(lds, c, Hb, (const bf16*)(ws + WS_WD2), nullptr, xb, 0.5f, nullptr, xb, ssq + SSQ3);
    }
    xcd_barrier(xbar);
    final_norm_phase(a, vcu, G);
}

extern "C" void kernel_launch(void* const* d_in, const int* in_sizes, int n_in, void* d_out, int out_size, void* d_ws, size_t ws_size, hipStream_t stream) {
    static int grid = 0;
    if (grid == 0) {
        if (n_in != 28 || ws_size < WS_END) { fprintf(stderr, "kernel_launch: unexpected inputs (n_in %d, ws %zu)\n", n_in, ws_size); grid = -1; return; }
        int dev = 0, cus = 0, per_cu = 0;
        hipGetDevice(&dev); hipDeviceGetAttribute(&cus, hipDeviceAttributeMultiprocessorCount, dev);
        if (hipFuncSetAttribute((const void*)hybrid_fwd, hipFuncAttributeMaxDynamicSharedMemorySize, LDS_BYTES) != hipSuccess) { fprintf(stderr, "kernel_launch: hipFuncSetAttribute failed\n"); grid = -1; return; }
        if (hipOccupancyMaxActiveBlocksPerMultiprocessor(&per_cu, (const void*)hybrid_fwd, NTHR, LDS_BYTES) != hipSuccess || per_cu < 1) { fprintf(stderr, "kernel_launch: occupancy query gave %d\n", per_cu); per_cu = 1; }
        (void)hipGetLastError();
        grid = cus * per_cu;
    }
    if (grid < 0) return;
    Args a{};
    for (int i = 0; i < 28; ++i) a.in[i] = (const float*)d_in[i];
    a.out = (float*)d_out; a.ws = (unsigned char*)d_ws;
    if (hipMemsetAsync((char*)d_ws + WS_BAR, 0, XCD_BAR_WORDS * 4 + 256, stream) != hipSuccess) { fprintf(stderr, "kernel_launch: memset of barrier words failed\n"); return; }
    void* args[] = {&a};
    hipError_t e = hipLaunchCooperativeKernel((const void*)hybrid_fwd, dim3(grid), dim3(NTHR), args, LDS_BYTES, stream);
    if (e != hipSuccess) fprintf(stderr, "kernel_launch: cooperative launch failed: %s (grid %d)\n", hipGetErrorString(e), grid);
}
```

```cpp
#include <hip/hip_runtime.h>
#include <hip/hip_cooperative_groups.h>
#include <cstdio>
#include <cstdint>
namespace cg = cooperative_groups;
#define DI __device__ __forceinline__
namespace pg8 {
#define PG8_LAS __attribute__((address_space(3)))
typedef unsigned short bf16_t;
typedef short bf16x8 __attribute__((ext_vector_type(8)));
typedef float f32x4 __attribute__((ext_vector_type(4)));
typedef unsigned u32x4 __attribute__((ext_vector_type(4)));
constexpr int BM = 256, BK = 64, HALF = 128, HTB = HALF * BK * 2  , STAGE_BYTES = 8 * HTB, NXCD = 8, WGM = 8;

__host__ __device__ __forceinline__ int lds_byte(int r, int c) { const int st = (r >> 4) * 2 + (c >> 5), rr = r & 15, cc = c & 31, ob = rr * 64 + cc * 2; return st * 1024 + (ob ^ (((ob >> 9) & 1) << 5)); }
__host__ __device__ __forceinline__ void stage_rc(int b, int& R, int& C) { const int st = b / 1024, sb = b % 1024, swz = sb ^ (((sb >> 9) & 1) << 5); R = (st >> 1) * 16 + swz / 64; C = (st & 1) * 32 + (swz % 64) / 2; }
__host__ __device__ __forceinline__ int perm32(int rho) { const int n = rho >> 4, i = rho & 15; return 8 * (i >> 2) + 4 * n + (i & 3); }

struct Unit { int pm, pn; };
struct Gemm { const bf16_t* A; const bf16_t* Bt; int M, N, K; };

struct StaticOrder {
    int nM, nN, nwg, G, c;
    __host__ __device__ void init(int M, int N, int G_, int c_) { nM = M / BM; nN = N / BM; nwg = nM * nN; G = G_; c = c_; }
    __host__ __device__ bool next(int i, Unit& u) const {
        const long L = (long)i * G + c; if (L >= nwg) return false;
        int wgid = (int)L; { const int q = nwg / NXCD, r = nwg % NXCD, xcd = wgid % NXCD, off = wgid / NXCD; wgid = (xcd < r ? xcd * (q + 1) : r * (q + 1) + (xcd - r) * q) + off; }
        const int nig = WGM * nN, gid = wgid / nig, fm = gid * WGM, gsz = (nM - fm) < WGM ? (nM - fm) : WGM;
        u.pm = fm + ((wgid % nig) % gsz); u.pn = (wgid % nig) / gsz; return true;
    }
    __device__ __forceinline__ void a_ready(const Unit&) const {}
    __device__ __forceinline__ void done(const Unit&) const {}
};

typedef unsigned u32x2 __attribute__((ext_vector_type(2)));
__device__ __forceinline__ unsigned pk_bf16(float lo, float hi) {
    typedef __bf16 bfx2 __attribute__((ext_vector_type(2))); typedef float fx2 __attribute__((ext_vector_type(2)));
    fx2 v = {lo, hi}; return __builtin_bit_cast(unsigned, __builtin_convertvector(v, bfx2));
}
constexpr float SSQ_SCALE = 4294967296.0f;
__device__ __forceinline__ float rs_from(const unsigned long long* ssq, int row, float inv_n) { return rsqrtf((float)ssq[row] * (inv_n / SSQ_SCALE) + 1e-6f); }
__device__ __forceinline__ float silu_f(float g) { return g * __builtin_amdgcn_rcpf(1.0f + __expf(-g)); }
__device__ __forceinline__ float sigm_f(float g) { return __builtin_amdgcn_rcpf(1.0f + __expf(-g)); }

struct EpiSwiGLU {
    static constexpr bool PERM = true, AFTER_DRAIN = false;
    bf16_t* H; int ldh; const unsigned long long* ssq;
    __device__ __forceinline__ void operator()(const f32x4 (&acc)[2][2][4][2], const Unit& u, int wr, int wc, int fr, int fq) const {
        const int row0 = u.pm * BM + wr * 64 + fr, col0 = u.pn * HALF + wc * 32 + 8 * fq;
#pragma unroll
        for (int ai = 0; ai < 2; ++ai)
#pragma unroll
            for (int m = 0; m < 4; ++m) {
                const int row = row0 + ai * HALF + m * 16; const float r = rs_from(ssq, row, 1.0f / 2048.0f);
                typedef float f32x2 __attribute__((ext_vector_type(2)));
                const float r2 = r * r, rk = r * -1.4426950408889634f;
                u32x4 w;
#pragma unroll
                for (int q = 0; q < 4; ++q) { const int n = q >> 1, i0 = 2 * (q & 1);
                    const f32x2 ag = (f32x2){acc[ai][0][m][n][i0], acc[ai][0][m][n][i0 + 1]}, au = (f32x2){acc[ai][1][m][n][i0], acc[ai][1][m][n][i0 + 1]};
                    const f32x2 t = ag * rk; f32x2 ex; ex.x = __builtin_amdgcn_exp2f(t.x); ex.y = __builtin_amdgcn_exp2f(t.y);
                    const f32x2 d = ex + 1.0f; f32x2 rc; rc.x = __builtin_amdgcn_rcpf(d.x); rc.y = __builtin_amdgcn_rcpf(d.y);
                    const f32x2 hh = ((ag * au) * r2) * rc;
                    w[q] = pk_bf16(hh.x, hh.y); }
                *(u32x4*)(H + (size_t)row * ldh + col0) = w;
            }
    }
};
struct EpiResid {
    static constexpr bool PERM = false, AFTER_DRAIN = false;
    const float* res0; const bf16_t* resb; float* out; bf16_t* xb; unsigned long long* ssq; float alpha;
    __device__ __forceinline__ void operator()(const f32x4 (&acc)[2][2][4][2], const Unit& u, int wr, int wc, int fr, int fq) const {
        const int row0 = u.pm * BM + wr * 64 + fr, col0 = u.pn * BM + wc * 32 + 4 * fq;
#pragma unroll
        for (int ai = 0; ai < 2; ++ai)
#pragma unroll
            for (int m = 0; m < 4; ++m) {
                const int row = row0 + ai * HALF + m * 16;
                float ss = 0.f;
#pragma unroll
                for (int bj = 0; bj < 2; ++bj)
#pragma unroll
                    for (int n = 0; n < 2; ++n) {
                        const size_t off = (size_t)row * 2048 + col0 + bj * HALF + n * 16;
                        f32x4 rv;
                        if (res0) rv = *(const f32x4*)(res0 + off);
                        else { const u32x2 rw = *(const u32x2*)(resb + off); rv = (f32x4){__uint_as_float(rw.x << 16), __uint_as_float(rw.x & 0xffff0000u), __uint_as_float(rw.y << 16), __uint_as_float(rw.y & 0xffff0000u)}; }
                        const f32x4 o = rv + acc[ai][bj][m][n] * alpha;
                        ss += (o[0] * o[0] + o[1] * o[1]) + (o[2] * o[2] + o[3] * o[3]);
                        if (out) *(f32x4*)(out + off) = o;
                        if (xb) { u32x2 w; w.x = pk_bf16(o[0], o[1]); w.y = pk_bf16(o[2], o[3]); *(u32x2*)(xb + off) = w; }
                    }
                ss += __shfl_xor(ss, 16); ss += __shfl_xor(ss, 32);
                if (fq == 0) atomicAdd(ssq + row, (unsigned long long)(ss * SSQ_SCALE));
            }
    }
};
struct EpiProj {
    static constexpr bool PERM = true, AFTER_DRAIN = false;
    bf16_t* P; int ldp; float* gsm; const unsigned long long* ssq; int n_main;
    __device__ __forceinline__ void operator()(const f32x4 (&acc)[2][2][4][2], const Unit& u, int wr, int wc, int fr, int fq) const {
        const int row0 = u.pm * BM + wr * 64 + fr;
#pragma unroll
        for (int ai = 0; ai < 2; ++ai)
#pragma unroll
            for (int m = 0; m < 4; ++m) {
                const int row = row0 + ai * HALF + m * 16; const float r = rs_from(ssq, row, 1.0f / 2048.0f);
                if (u.pn < n_main) {
                    const int col0 = u.pn * BM + wc * 32 + 8 * fq;
#pragma unroll
                    for (int bj = 0; bj < 2; ++bj) { const f32x4 v0 = acc[ai][bj][m][0] * r, v1 = acc[ai][bj][m][1] * r;
                        u32x4 w; w.x = pk_bf16(v0[0], v0[1]); w.y = pk_bf16(v0[2], v0[3]); w.z = pk_bf16(v1[0], v1[1]); w.w = pk_bf16(v1[2], v1[3]);
                        *(u32x4*)(P + (size_t)row * ldp + col0 + bj * HALF) = w; }
                } else if (wc < 2) {
                    float* gp = gsm + (size_t)row * 64 + wc * 32 + 8 * fq;
                    *(f32x4*)gp = acc[ai][0][m][0] * r; *(f32x4*)(gp + 4) = acc[ai][0][m][1] * r;
                }
            }
    }
};

template <class Epi, class Sched, bool ALIGN_EPI = false, bool SP2 = false>
__device__ __forceinline__ void gemm_phase(PG8_LAS unsigned char* lds, const Gemm g, const Sched& S, const Epi& E) {
    int tid_ = threadIdx.x; asm volatile("" : "+v"(tid_)); const int tid = tid_, wid = __builtin_amdgcn_readfirstlane(tid >> 6), lane = tid & 63, wr = wid >> 2, wc = wid & 3, fr = lane & 15, fq = lane >> 4;
    const int K = g.K, nt = K / BK;
    unsigned voffA[2], voffB[2];
#pragma unroll
    for (int i = 0; i < 2; ++i) { int R, C; stage_rc(tid * 16 + i * 8192, R, C); const int Rb = Epi::PERM ? ((R & ~31) + perm32(R & 31)) : R;
        voffA[i] = (unsigned)(R * K + C) * 2u; voffB[i] = (unsigned)(Rb * K + C) * 2u; }
    const size_t kstep = (size_t)(BK * 2);
    const size_t hstep = (size_t)HALF * K * 2;
    const size_t tstep = 2 * hstep;
    const unsigned ldsw = (unsigned)wid * 1024u;
    const int aoff = lds_byte(wr * 64 + fr, fq * 8), boff = lds_byte(wc * 32 + fr, fq * 8);
#define PG8_SA(b, h) (((b) * 2 + (h)) * HTB)
#define PG8_SB(b, h) ((4 + (b) * 2 + (h)) * HTB)
#define PG8_STAGE(bufoff, gbase, voff) do { _Pragma("unroll") for (int _i = 0; _i < 2; ++_i) \
        __builtin_amdgcn_global_load_lds((const unsigned*)((const char*)(gbase) + (voff)[_i]), (PG8_LAS unsigned*)(lds + (bufoff) + ldsw + _i * 8192), 16, 0, 0); } while (0)
#define PG8_LDA(dst, b, h) do { _Pragma("unroll") for (int m = 0; m < 4; ++m) _Pragma("unroll") for (int k = 0; k < 2; ++k) dst[m][k] = *(const PG8_LAS bf16x8*)(lds + PG8_SA(b, h) + aoff + m * 2048 + k * 1024); } while (0)
#define PG8_LDB(dst, b, h) do { _Pragma("unroll") for (int n = 0; n < 2; ++n) _Pragma("unroll") for (int k = 0; k < 2; ++k) dst[n][k] = *(const PG8_LAS bf16x8*)(lds + PG8_SB(b, h) + boff + n * 2048 + k * 1024); } while (0)
#define PG8_MMA(ai, bj, At, Bt) do { __builtin_amdgcn_s_setprio(1); _Pragma("unroll") for (int m = 0; m < 4; ++m) _Pragma("unroll") for (int n = 0; n < 2; ++n) _Pragma("unroll") for (int k = 0; k < 2; ++k) \
        acc[ai][bj][m][n] = __builtin_amdgcn_mfma_f32_16x16x32_bf16(Bt[n][k], At[m][k], acc[ai][bj][m][n], 0, 0, 0); __builtin_amdgcn_s_setprio(0); } while (0)
#define PG8_WAIT_V(n) asm volatile("s_waitcnt vmcnt(" #n ")" ::: "memory")
#define PG8_WAIT_L(n) asm volatile("s_waitcnt lgkmcnt(" #n ")" ::: "memory")
#define PG8_BAR __builtin_amdgcn_s_barrier()
#define PG8_SCHED __builtin_amdgcn_sched_barrier(0)
    Unit cur, nxt; int ui = 0;
    if (!S.next(0, cur)) return;
    f32x4 acc[2][2][4][2];
#pragma unroll
    for (int a = 0; a < 2; ++a)
#pragma unroll
        for (int b = 0; b < 2; ++b)
#pragma unroll
            for (int m = 0; m < 4; ++m)
#pragma unroll
                for (int n = 0; n < 2; ++n) acc[a][b][m][n] = (f32x4){0.f, 0.f, 0.f, 0.f};
    bf16x8 At[4][2], B0[2][2], B1[2][2];
    const char* cA = (const char*)g.A + (size_t)cur.pm * tstep; const char* cB = (const char*)g.Bt + (size_t)cur.pn * tstep;
    S.a_ready(cur);
    if constexpr (SP2) {
        PG8_STAGE(PG8_SB(0, 0), cB, voffB); PG8_STAGE(PG8_SB(0, 1), cB + hstep, voffB); PG8_STAGE(PG8_SA(0, 0), cA, voffA); PG8_STAGE(PG8_SA(0, 1), cA + hstep, voffA);
        if (wr == 1) PG8_BAR;
        PG8_WAIT_V(2); PG8_BAR;
        PG8_STAGE(PG8_SB(1, 0), cB + kstep, voffB); PG8_STAGE(PG8_SA(1, 0), cA + kstep, voffA); PG8_STAGE(PG8_SB(1, 1), cB + hstep + kstep, voffB);
        PG8_WAIT_V(6); PG8_BAR;
    } else {
        PG8_STAGE(PG8_SB(0, 0), cB, voffB); PG8_STAGE(PG8_SA(0, 0), cA, voffA); PG8_STAGE(PG8_SB(0, 1), cB + hstep, voffB); PG8_STAGE(PG8_SA(0, 1), cA + hstep, voffA);
        if (wr == 1) PG8_BAR;
        PG8_WAIT_V(4); PG8_BAR;
        PG8_STAGE(PG8_SB(1, 0), cB + kstep, voffB); PG8_STAGE(PG8_SA(1, 0), cA + kstep, voffA); PG8_STAGE(PG8_SB(1, 1), cB + hstep + kstep, voffB);
        PG8_WAIT_V(6); PG8_BAR;
    }
    for (;;) {
        const bool has_next = S.next(ui + 1, nxt);
        const char* nA = has_next ? (const char*)g.A + (size_t)nxt.pm * tstep : cA; const char* nB = has_next ? (const char*)g.Bt + (size_t)nxt.pn * tstep : cB;
        for (int t = 0; t < nt; t += 2) {
            const bool last = (t == nt - 2);
            const char* a1 = cA + (size_t)(t + 1) * kstep;
            const char* a2 = last ? nA : cA + (size_t)(t + 2) * kstep; const char* b2 = last ? nB : cB + (size_t)(t + 2) * kstep;
            const char* a3 = a2 + kstep; const char* b3 = b2 + kstep;
            if (last && has_next) S.a_ready(nxt);
            if constexpr (SP2) {
            PG8_LDB(B0, 0, 0); PG8_LDB(B1, 0, 1); PG8_SCHED; PG8_LDA(At, 0, 0); PG8_STAGE(PG8_SA(1, 1), a1 + hstep, voffA);
            PG8_WAIT_V(8); PG8_WAIT_L(0); PG8_BAR; PG8_MMA(0, 0, At, B0); PG8_MMA(0, 1, At, B1); PG8_BAR; PG8_SCHED;
            PG8_LDA(At, 0, 1); PG8_STAGE(PG8_SB(0, 0), b2, voffB); PG8_STAGE(PG8_SB(0, 1), b2 + hstep, voffB); PG8_STAGE(PG8_SA(0, 0), a2, voffA);
            PG8_WAIT_V(8); PG8_WAIT_L(0); PG8_BAR; PG8_MMA(1, 0, At, B0); PG8_MMA(1, 1, At, B1); PG8_BAR; PG8_SCHED;
            PG8_LDB(B0, 1, 0); PG8_LDB(B1, 1, 1); PG8_SCHED; PG8_LDA(At, 1, 0); PG8_STAGE(PG8_SA(0, 1), a2 + hstep, voffA);
            PG8_WAIT_V(8); PG8_WAIT_L(0); PG8_BAR; PG8_MMA(0, 0, At, B0); PG8_MMA(0, 1, At, B1); PG8_BAR; PG8_SCHED;
            PG8_LDA(At, 1, 1); PG8_STAGE(PG8_SB(1, 0), b3, voffB); PG8_STAGE(PG8_SB(1, 1), b3 + hstep, voffB); PG8_STAGE(PG8_SA(1, 0), a3, voffA);
            PG8_WAIT_V(8); PG8_WAIT_L(0); PG8_BAR; PG8_MMA(1, 0, At, B0); PG8_MMA(1, 1, At, B1); PG8_BAR; PG8_SCHED;
            } else {
            PG8_LDB(B0, 0, 0); PG8_SCHED; PG8_LDA(At, 0, 0); PG8_STAGE(PG8_SA(1, 1), a1 + hstep, voffA);
            PG8_WAIT_L(8); PG8_BAR; PG8_WAIT_L(0); PG8_MMA(0, 0, At, B0); PG8_BAR; PG8_SCHED;
            PG8_LDB(B1, 0, 1); PG8_STAGE(PG8_SB(0, 0), b2, voffB);
            PG8_BAR; PG8_WAIT_L(0); PG8_MMA(0, 1, At, B1); PG8_BAR;
            PG8_LDA(At, 0, 1); PG8_STAGE(PG8_SA(0, 0), a2, voffA);
            PG8_BAR; PG8_WAIT_L(0); PG8_MMA(1, 0, At, B0); PG8_BAR; PG8_SCHED;
            PG8_STAGE(PG8_SB(0, 1), b2 + hstep, voffB);
            PG8_WAIT_V(6); PG8_BAR; PG8_MMA(1, 1, At, B1); PG8_BAR;
            PG8_LDB(B0, 1, 0); PG8_SCHED; PG8_LDA(At, 1, 0); PG8_STAGE(PG8_SA(0, 1), a2 + hstep, voffA);
            PG8_WAIT_L(8); PG8_BAR; PG8_WAIT_L(0); PG8_MMA(0, 0, At, B0); PG8_BAR; PG8_SCHED;
            PG8_LDB(B1, 1, 1); PG8_STAGE(PG8_SB(1, 0), b3, voffB);
            PG8_BAR; PG8_WAIT_L(0); PG8_MMA(0, 1, At, B1); PG8_BAR;
            PG8_LDA(At, 1, 1); PG8_STAGE(PG8_SA(1, 0), a3, voffA);
            PG8_BAR; PG8_WAIT_L(0); PG8_MMA(1, 0, At, B0); PG8_BAR; PG8_SCHED;
            PG8_STAGE(PG8_SB(1, 1), b3 + hstep, voffB);
            PG8_WAIT_V(6); PG8_BAR; PG8_MMA(1, 1, At, B1); PG8_BAR;
            }
        }
        if constexpr (ALIGN_EPI) { if (wr == 0) PG8_BAR; }
        if constexpr (!Epi::AFTER_DRAIN) { E(acc, cur, wr, wc, fr, fq); S.done(cur); }
        if (!has_next) break;
#pragma unroll
        for (int a = 0; a < 2; ++a)
#pragma unroll
            for (int b = 0; b < 2; ++b)
#pragma unroll
                for (int m = 0; m < 4; ++m)
#pragma unroll
                    for (int n = 0; n < 2; ++n) acc[a][b][m][n] = (f32x4){0.f, 0.f, 0.f, 0.f};
        cur = nxt; cA = nA; cB = nB; ++ui;
        if constexpr (ALIGN_EPI) { if (wr == 1) PG8_BAR; }
    }
    PG8_WAIT_V(0);
    if constexpr (!ALIGN_EPI) { if (wr == 0) PG8_BAR; }
    PG8_BAR;
    if constexpr (Epi::AFTER_DRAIN) { E.fused(acc, cur, wr, wc, fr, fq, lds, wid, lane); S.done(cur); }
#undef PG8_SA
#undef PG8_SB
#undef PG8_STAGE
#undef PG8_LDA
#undef PG8_LDB
#undef PG8_MMA
#undef PG8_WAIT_V
#undef PG8_WAIT_L
#undef PG8_BAR
#undef PG8_SCHED
}
}

constexpr int DM = 2048, FF = 5632, NPROMPT = 8192, NSAMP = 128, NTOK = 8320, MP = 8448, SEQ = 2048, NBATCH = 4;
constexpr int NGU = 2 * FF;
constexpr int LDP = 14848;
constexpr int NPROJ = 15104;
constexpr int PQ = 0, PK = 1024, PV = 2048, POG = 4096, PZ = 6144, PXBC = 8192, PGATE = 10752;
constexpr int XBC = 2560, IN_DIM = 14888;
constexpr float NEG_INIT = -1e30f;
constexpr size_t O_Y = 0, O_PCONV = 17039360, O_PC = 17070080, O_PN = 19167232, O_PM = 19171328, O_PSSM = 19171344,
                 O_SCONV = 20219920, O_SC = 21202960, O_SN = 88311824, O_SM = 88442896, O_SSSM = 88443408;
constexpr size_t MiB = 1u << 20;
constexpr size_t WS_SSQ = 0, WS_BAR = 1 * MiB, WS_WGU1 = 2 * MiB, WS_WD1 = 46 * MiB, WS_WIN = 68 * MiB, WS_WOUT = 127 * MiB, WS_WGU2 = 135 * MiB, WS_WD2 = 179 * MiB,
                 WS_XB = 202 * MiB, WS_MERGED = 235 * MiB, WS_X1 = 268 * MiB, WS_H = 334 * MiB, WS_PROJ = 425 * MiB, WS_GSM = 665 * MiB, WS_HML = 668 * MiB, WS_YS = 734 * MiB, WS_XA = 800 * MiB, WS_END = 844 * MiB;
constexpr int SSQ0 = 0, SSQ1 = MP, SSQ2 = 2 * MP, SSQ3 = 3 * MP, SSQA = 4 * MP, SSQB = 8 * MP, SSQ_WORDS = 10 * MP;
constexpr int LDS_BYTES = 163840;
constexpr int NWAVES = 8, NTHR = 512;

#define LAS __attribute__((address_space(3)))
typedef unsigned short bf16;
typedef float f32x4 __attribute__((ext_vector_type(4)));
typedef short bf16x8 __attribute__((ext_vector_type(8)));
typedef unsigned u32x4 __attribute__((ext_vector_type(4)));
typedef unsigned u32x2 __attribute__((ext_vector_type(2)));
typedef unsigned long long u64;
typedef float f32x2 __attribute__((ext_vector_type(2)));
using pg8::pk_bf16; using pg8::SSQ_SCALE; using pg8::rs_from; using pg8::silu_f; using pg8::sigm_f;
DI float bf2f(unsigned v) { return __uint_as_float(v << 16); }
DI bf16 f2bf(float f) { return (bf16)(pk_bf16(f, 0.f) & 0xffffu); }
DI float wave_sum(float v) {
#pragma unroll
    for (int o = 1; o < 64; o <<= 1) v += __shfl_xor(v, o);
    return v;
}
typedef short s16x4 __attribute__((ext_vector_type(4)));
DI s16x4 lds_tr4(const LAS unsigned short* p) { return __builtin_amdgcn_ds_read_tr16_b64_v4i16((LAS s16x4*)p); }
DI f32x4 mfma16(bf16x8 a, bf16x8 b, f32x4 c) { return __builtin_amdgcn_mfma_f32_16x16x32_bf16(a, b, c, 0, 0, 0); }
DI float log_sigmoid(float x) { return fminf(x, 0.f) - log1pf(__expf(-fabsf(x))); }
DI float softplus_f(float x) { return fmaxf(x, 0.f) + log1pf(__expf(-fabsf(x))); }

struct Args { const float* in[28]; float* out; unsigned char* ws; };

DI int map_in(int n) {
    if (n < 4096) return n;
    if (n < 4100) return 14848 + (n - 4096);
    if (n < 4104) return 14852 + (n - 4100);
    if (n < 6152) return POG + (n - 4104);
    if (n < 8200) return PZ + (n - 6152);
    if (n < 10760) return PXBC + (n - 8200);
    if (n < 10792) return 14856 + (n - 10760);
    return PGATE + (n - 10792);
}
struct TItem { const float* W; bf16* WT; const float* wk; int K, N, mode, k0, n0; };
DI TItem decode_item(const Args& a, int it) {
    constexpr int I_G = (DM / 64) * (FF / 64), I_D = (FF / 64) * (DM / 64), I_IN = (DM / 64) * ((IN_DIM + 63) / 64), I_O = (DM / 64) * (DM / 64);
    unsigned char* ws = a.ws; TItem d; int r = it, nblk;
    if (r < I_G) { d.W = a.in[8]; d.WT = (bf16*)(ws + WS_WGU1); d.wk = a.in[7]; d.K = DM; d.N = FF; d.mode = 1; }
    else if ((r -= I_G) < I_G) { d.W = a.in[9]; d.WT = (bf16*)(ws + WS_WGU1); d.wk = a.in[7]; d.K = DM; d.N = FF; d.mode = 2; }
    else if ((r -= I_G) < I_IN) { d.W = a.in[12]; d.WT = (bf16*)(ws + WS_WIN); d.wk = a.in[11]; d.K = DM; d.N = IN_DIM; d.mode = 3; }
    else if ((r -= I_IN) < I_D) { d.W = a.in[10]; d.WT = (bf16*)(ws + WS_WD1); d.wk = nullptr; d.K = FF; d.N = DM; d.mode = 0; }
    else if ((r -= I_D) < I_G) { d.W = a.in[24]; d.WT = (bf16*)(ws + WS_WGU2); d.wk = a.in[23]; d.K = DM; d.N = FF; d.mode = 1; }
    else if ((r -= I_G) < I_O) { d.W = a.in[22]; d.WT = (bf16*)(ws + WS_WOUT); d.wk = nullptr; d.K = DM; d.N = DM; d.mode = 0; }
    else if ((r -= I_O) < I_D) { d.W = a.in[26]; d.WT = (bf16*)(ws + WS_WD2); d.wk = nullptr; d.K = FF; d.N = DM; d.mode = 0; }
    else { r -= I_D; d.W = a.in[25]; d.WT = (bf16*)(ws + WS_WGU2); d.wk = a.in[23]; d.K = DM; d.N = FF; d.mode = 2; }
    nblk = (d.N + 63) / 64; d.k0 = 64 * (r / nblk); d.n0 = 64 * (r % nblk);
    return d;
}
DI void titem_load(const TItem& d, f32x4 (&v)[16], float (&kw)[16], int lane) {
    const int n = d.n0 + 4 * (lane & 15), kq = lane >> 4; const bool ok = n < d.N;
#pragma unroll
    for (int i = 0; i < 16; ++i) { v[i] = (f32x4){0.f, 0.f, 0.f, 0.f}; if (ok) v[i] = __builtin_nontemporal_load((const f32x4*)(d.W + (size_t)(d.k0 + 4 * i + kq) * d.N + n)); }
#pragma unroll
    for (int i = 0; i < 16; ++i) kw[i] = d.wk ? d.wk[d.k0 + 4 * i + kq] : 1.f;
}
DI void titem_store(const TItem& d, const f32x4 (&v)[16], const float (&kw)[16], LAS float* scr, int lane) {
    const int kq = lane >> 4, nl4 = 4 * (lane & 15);
#pragma unroll
    for (int i = 0; i < 16; ++i) { LAS float* p = scr + (4 * i + kq) * 65 + nl4; const f32x4 x = v[i] * kw[i]; p[0] = x[0]; p[1] = x[1]; p[2] = x[2]; p[3] = x[3]; }
    asm volatile("s_waitcnt lgkmcnt(0)" ::: "memory");
    const int c = lane & 7;
#pragma unroll
    for (int j = 0; j < 8; ++j) { const int nl = (lane >> 3) + 8 * j, n = d.n0 + nl; const LAS float* s = scr + (8 * c) * 65 + nl;
        if (n < d.N) {
            int dst; float sc = 1.f;
            if (d.mode == 0) dst = n; else if (d.mode == 1) dst = (n >> 7) * 256 + (n & 127); else if (d.mode == 2) dst = (n >> 7) * 256 + 128 + (n & 127); else { dst = map_in(n); if (n < 1024) sc = 0.0625f; }
            u32x4 o; o.x = pk_bf16(s[0 * 65] * sc, s[1 * 65] * sc); o.y = pk_bf16(s[2 * 65] * sc, s[3 * 65] * sc); o.z = pk_bf16(s[4 * 65] * sc, s[5 * 65] * sc); o.w = pk_bf16(s[6 * 65] * sc, s[7 * 65] * sc);
            *(u32x4*)(d.WT + (size_t)dst * d.K + d.k0 + 8 * c) = o; } }
    asm volatile("s_waitcnt lgkmcnt(0)" ::: "memory");
}
constexpr int CV_I_G = (DM / 64) * (FF / 64), CV_I_D = (FF / 64) * (DM / 64), CV_I_IN = (DM / 64) * ((IN_DIM + 63) / 64), CV_I_O = (DM / 64) * (DM / 64);
constexpr int CV_PROLOGUE_END = 2 * CV_I_G + CV_I_IN, CV_G1TAIL_END = CV_PROLOGUE_END + CV_I_D + CV_I_G, CV_END = CV_G1TAIL_END + CV_I_O + CV_I_D + CV_I_G;
DI void convert_items(LAS unsigned char* lds, const Args& a, int first, int last, int widx, int nworkers) {
    int tid_ = threadIdx.x; asm volatile("" : "+v"(tid_)); const int tid = tid_, lane = tid & 63, wave = __builtin_amdgcn_readfirstlane(tid >> 6);
    LAS float* scr = (LAS float*)(lds + wave * 16640);
    int it = first + widx;
    if (it < last) {
        TItem d = decode_item(a, it); f32x4 cur[16]; float ckw[16];
        titem_load(d, cur, ckw, lane);
        for (;;) {
            const int itn = it + nworkers; const bool more = itn < last;
            TItem dn = d; f32x4 nxt[16]; float nkw[16];
            if (more) { dn = decode_item(a, itn); titem_load(dn, nxt, nkw, lane); }
            titem_store(d, cur, ckw, scr, lane);
            if (!more) break;
#pragma unroll
            for (int i = 0; i < 16; ++i) { cur[i] = nxt[i]; ckw[i] = nkw[i]; }
            d = dn; it = itn;
        }
    }
}
DI void p0_prologue(LAS unsigned char* lds, const Args& a, int vcu, int G) {
    int tid_ = threadIdx.x; asm volatile("" : "+v"(tid_)); const int tid = tid_, lane = tid & 63, wave = __builtin_amdgcn_readfirstlane(tid >> 6);
    unsigned char* ws = a.ws;
    LAS float* scr = (LAS float*)(lds + wave * 16640);
    const int gw = vcu * NWAVES + wave, NGW = G * NWAVES;
    { u64* q = (u64*)(ws + WS_SSQ); for (int i = (int)(blockIdx.x * NTHR + tid); i < SSQ_WORDS - MP; i += G * NTHR) q[MP + i] = 0ull; }
    constexpr int I_G = (DM / 64) * (FF / 64), I_D = (FF / 64) * (DM / 64), I_IN = (DM / 64) * ((IN_DIM + 63) / 64), I_O = (DM / 64) * (DM / 64);
    constexpr int NITEMS = 4 * I_G + 2 * I_D + I_IN + I_O;
    bf16* xb = (bf16*)(ws + WS_XB); u64* ssq0 = (u64*)(ws + WS_SSQ) + SSQ0;
    for (int m = gw; m < NTOK; m += NGW) {
        const float* xr = m < NPROMPT ? a.in[0] + (size_t)m * DM : a.in[1] + (size_t)(m - NPROMPT) * DM;
        f32x4 v[8];
#pragma unroll
        for (int j = 0; j < 8; ++j) v[j] = *(const f32x4*)(xr + 4 * lane + 256 * j);
        float ss = 0.f;
#pragma unroll
        for (int j = 0; j < 8; ++j) { ss += (v[j][0] * v[j][0] + v[j][1] * v[j][1]) + (v[j][2] * v[j][2] + v[j][3] * v[j][3]);
            u32x2 w; w.x = pk_bf16(v[j][0], v[j][1]); w.y = pk_bf16(v[j][2], v[j][3]); *(u32x2*)(xb + (size_t)m * DM + 4 * lane + 256 * j) = w; }
        ss = wave_sum(ss);
        if (lane == 0) ssq0[m] = (u64)(ss * SSQ_SCALE);
    }
    convert_items(lds, a, 0, CV_PROLOGUE_END, gw, NGW);
}

DI void conv_pass(const Args& a, int vcu, int G) {
    int tid_ = threadIdx.x; asm volatile("" : "+v"(tid_)); const int tid = tid_;
    const bf16* proj = (const bf16*)(a.ws + WS_PROJ); bf16* XA = (bf16*)(a.ws + WS_XA);
    const float* cwt = a.in[16]; const float* cbs = a.in[17]; const float* stc = a.in[2];
    const int gt = vcu * NTHR + tid, NGT = G * NTHR;
    constexpr int NCG = XBC / 8, RUN = 16, NRUN = NPROMPT / RUN;
    for (int item = gt; item < NRUN * NCG + NSAMP * NCG; item += NGT) {
        const bool samp = item >= NRUN * NCG; const int it2 = samp ? item - NRUN * NCG : item;
        const int cg8 = it2 % NCG, run = it2 / NCG, ch = 8 * cg8;
        float wv[4][8], bs[8];
#pragma unroll
        for (int jj = 0; jj < 4; ++jj) { const f32x4 w0 = *(const f32x4*)(cwt + jj * XBC + ch), w1 = *(const f32x4*)(cwt + jj * XBC + ch + 4);
#pragma unroll
            for (int e = 0; e < 4; ++e) { wv[jj][e] = w0[e]; wv[jj][4 + e] = w1[e]; } }
        { const f32x4 b0 = *(const f32x4*)(cbs + ch), b1 = *(const f32x4*)(cbs + ch + 4);
#pragma unroll
          for (int e = 0; e < 4; ++e) { bs[e] = b0[e]; bs[4 + e] = b1[e]; } }
        if (!samp) {
            const int b = run / (SEQ / RUN), t0 = (run % (SEQ / RUN)) * RUN;
            const bf16* base = proj + ((size_t)b * SEQ) * LDP + PXBC + ch;
            u32x4 rw[RUN + 3];
#pragma unroll
            for (int r = 0; r < RUN + 3; ++r) { const int tt = t0 - 3 + r; rw[r] = (u32x4){0u, 0u, 0u, 0u}; if (tt >= 0) rw[r] = *(const u32x4*)(base + (size_t)tt * LDP); }
#pragma unroll
            for (int r = 0; r < RUN; ++r) { float o[8];
#pragma unroll
                for (int e = 0; e < 8; ++e) { float acc = bs[e];
#pragma unroll
                    for (int jj = 0; jj < 4; ++jj) { const unsigned word = rw[r + jj][e >> 1]; acc += wv[jj][e] * ((e & 1) ? __uint_as_float(word & 0xffff0000u) : __uint_as_float(word << 16)); }
                    o[e] = silu_f(acc); }
                u32x4 ov; ov.x = pk_bf16(o[0], o[1]); ov.y = pk_bf16(o[2], o[3]); ov.z = pk_bf16(o[4], o[5]); ov.w = pk_bf16(o[6], o[7]);
                *(u32x4*)(XA + ((size_t)b * SEQ + t0 + r) * XBC + ch) = ov; }
        } else {
            const int bs_i = run; const float* st = stc + (size_t)bs_i * 3 * XBC + ch; const u32x4 nw = *(const u32x4*)(proj + ((size_t)NPROMPT + bs_i) * LDP + PXBC + ch);
            float o[8];
#pragma unroll
            for (int e = 0; e < 8; ++e) { const unsigned word = nw[e >> 1]; const float xv = (e & 1) ? __uint_as_float(word & 0xffff0000u) : __uint_as_float(word << 16);
                o[e] = silu_f(bs[e] + wv[0][e] * st[e] + wv[1][e] * st[XBC + e] + wv[2][e] * st[2 * XBC + e] + wv[3][e] * xv); }
            u32x4 ov; ov.x = pk_bf16(o[0], o[1]); ov.y = pk_bf16(o[2], o[3]); ov.z = pk_bf16(o[4], o[5]); ov.w = pk_bf16(o[6], o[7]);
            *(u32x4*)(XA + ((size_t)NPROMPT + bs_i) * XBC + ch) = ov;
        }
    }
}

constexpr int ML_CT = 0, ML_KS = 34320, ML_VT = 101904, ML_VTW = 124432, ML_SB = 146960, ML_SBN = 516, ML_SV = 88;
DI float mlstm_scan(float ig0, float ig1, float fg0, float fg1, float ib, float fb, int lane, LAS float* sb, float mst) {
    const float li0 = ig0 + ib, li1 = ig1 + ib, lf0 = log_sigmoid(fg0 + fb), lf1 = log_sigmoid(fg1 + fb);
    float s = lf0 + lf1;
#pragma unroll
    for (int o = 1; o < 64; o <<= 1) { const float tv = __shfl_up(s, o); if (lane >= o) s += tv; }
    const float b1 = s, b0 = s - lf1, g0 = li0 - b0, g1 = li1 - b1;
    float pmx = fmaxf(g0, g1);
#pragma unroll
    for (int o = 1; o < 64; o <<= 1) { const float tv = __shfl_up(pmx, o); if (lane >= o) pmx = fmaxf(pmx, tv); }
    float prev = __shfl_up(pmx, 1); if (lane == 0) prev = -INFINITY;
    const float M0 = fmaxf(mst, fmaxf(prev, g0)), M1 = fmaxf(mst, pmx);
    const float M127 = __shfl(M1, 63), b127 = __shfl(b1, 63);
    *(LAS f32x2*)(sb + 2 * lane) = (f32x2){g0, g1}; *(LAS f32x2*)(sb + 128 + 2 * lane) = (f32x2){b0, b1}; *(LAS f32x2*)(sb + 256 + 2 * lane) = (f32x2){M0, M1};
    *(LAS f32x2*)(sb + 384 + 2 * lane) = (f32x2){__expf(g0 - M127), __expf(g1 - M127)};
    if (lane == 0) { sb[512] = __expf(mst - M127); sb[513] = b127 + M127; sb[514] = mst; }
    return b127 + M127;
}
DI void mlstm_prompt_unit(LAS unsigned char* lds, int unit, const bf16* proj, const float* gsm, const float* i_bias, const float* f_bias,
                          bf16* hml, u64* ssqA, float* pC, float* pn, float* pm, bool atom) {
    int tid_ = threadIdx.x; asm volatile("" : "+v"(tid_)); const int tid = tid_, lane = tid & 63, w = __builtin_amdgcn_readfirstlane(tid >> 6), fr = lane & 15, fq = lane >> 4;
    const int bh = unit >> 3, j = unit & 7, b = bh >> 2, h = bh & 3;
    LAS bf16* CT = (LAS bf16*)(lds + ML_CT); LAS bf16* Ks = (LAS bf16*)(lds + ML_KS); LAS bf16* Vt = (LAS bf16*)(lds + ML_VT); LAS bf16* Vtw = (LAS bf16*)(lds + ML_VTW);
    LAS float* sbuf = (LAS float*)(lds + ML_SB);
    for (int i = tid; i < 65 * 264 / 2; i += NTHR) ((LAS unsigned*)CT)[i] = 0u;
    for (int i = tid; i < 2 * 128 * ML_SV / 2; i += NTHR) ((LAS unsigned*)Vt)[i] = 0u;
    __syncthreads();
    if (tid < 128) Vt[tid * ML_SV + 64] = (bf16)0x3F80u;
    f32x4 Cacc[2][5];
#pragma unroll
    for (int e = 0; e < 2; ++e)
#pragma unroll
        for (int d = 0; d < 5; ++d) Cacc[e][d] = (f32x4){0.f, 0.f, 0.f, 0.f};
    const float ib = i_bias[h], fb = f_bias[h];
    const size_t tokb = (size_t)b * SEQ;
    u32x4 kreg[8], vreg[2]; bf16x8 qnx[8]; float mrun = NEG_INIT;
    const unsigned koff = (unsigned)((tid >> 5) * (LDP * 2) + (tid & 31) * 16), voff = (unsigned)((tid >> 2) * (LDP * 2) + (tid & 3) * 32);
    const unsigned qoff = (unsigned)((16 * w + fr) * (LDP * 2) + fq * 16), goff = (unsigned)lane * 512u, hoff = (unsigned)((16 * w + fr) * (DM * 2) + fq * 8);
    const char* pk0 = (const char*)(proj + tokb * LDP + PK + h * 256); const char* pv0 = (const char*)(proj + tokb * LDP + PV + h * 512 + 64 * j);
    const char* pq0 = (const char*)(proj + tokb * LDP + PQ + h * 256); const char* pg0 = (const char*)(gsm + tokb * 64 + h); char* ph0 = (char*)(hml + tokb * DM + h * 512 + 64 * j);
#define ML_LOAD_KV(c_) do { const size_t cb_ = (size_t)(c_) * 128 * LDP * 2; \
        _Pragma("unroll") for (int i = 0; i < 8; ++i) kreg[i] = *(const u32x4*)(pk0 + cb_ + (size_t)i * 16 * LDP * 2 + koff); \
        _Pragma("unroll") for (int i = 0; i < 2; ++i) vreg[i] = *(const u32x4*)(pv0 + cb_ + 16 * i + voff); \
        _Pragma("unroll") for (int kk = 0; kk < 8; ++kk) qnx[kk] = *(const bf16x8*)(pq0 + cb_ + 64 * kk + qoff); \
        } while (0)
#define ML_LOAD_G(c_) do { { const char* gp_ = pg0 + (size_t)(c_) * 128 * 256 + goff; gz[0] = *(const float*)gp_; gz[1] = *(const float*)(gp_ + 256); gz[2] = *(const float*)(gp_ + 16); gz[3] = *(const float*)(gp_ + 256 + 16); } } while (0)
    ML_LOAD_KV(0);
    if (w == 0) { float gz[4]; ML_LOAD_G(0); mrun = mlstm_scan(gz[0], gz[1], gz[2], gz[3], ib, fb, lane, sbuf, mrun); }
    __syncthreads();
#define LAUNDER(p) asm volatile("" : "+v"(p))
    for (int c = 0; c < 16; ++c) {
        const size_t tok0 = tokb + (size_t)c * 128;
        LAS float* sc = sbuf + (c & 1) * ML_SBN; LAS float* sn = sbuf + ((c + 1) & 1) * ML_SBN;
        const int t = 16 * w + fr;
        LAS bf16* ksw = Ks + (tid >> 5) * 264 + 8 * (tid & 31); LAS bf16* vtw_ = Vt + (tid >> 2) * ML_SV + 16 * (tid & 3);
        const LAS bf16* ksr = Ks + fr * 264 + 8 * fq; const LAS bf16* ctr = CT + fr * 264 + 8 * fq; const LAS bf16* vtr = Vt + (4 * fq + (fr >> 2)) * ML_SV + 4 * (fr & 3); const LAS bf16* vtwr = Vtw + (8 * fq + (fr >> 2)) * ML_SV + 4 * (fr & 3);
        const LAS bf16* kgr = Ks + (8 * fq + (fr >> 2)) * 264 + 32 * w + 4 * (fr & 3); LAS bf16* ctw = CT + (4 * fq) * 264 + 32 * w + fr;
        const LAS float* scq = sc + 4 * fq; const LAS float* sct = sc + t; const LAS float* scs = sc + (tid >> 2);
        LAUNDER(ksw); LAUNDER(vtw_); LAS bf16* vtww = vtw_ + (ML_VTW - ML_VT) / 2; LAUNDER(ksr); LAUNDER(ctr); LAUNDER(vtr); LAUNDER(vtwr); LAUNDER(kgr); LAUNDER(ctw); LAUNDER(scq); LAUNDER(sct); LAUNDER(scs);
        bf16x8 qf[8];
#pragma unroll
        for (int kk = 0; kk < 8; ++kk) qf[kk] = qnx[kk];
#pragma unroll
        for (int i = 0; i < 8; ++i) *(LAS u32x4*)(ksw + i * 16 * 264) = kreg[i];
        {   const float we = scs[384];
#pragma unroll
            for (int i = 0; i < 2; ++i) { u32x4 sw_;
#pragma unroll
                for (int e2 = 0; e2 < 4; ++e2) { const unsigned word = vreg[i][e2]; sw_[e2] = pk_bf16(__uint_as_float(word << 16) * we, __uint_as_float(word & 0xffff0000u) * we); }
                *(LAS u32x4*)(vtw_ + 8 * i) = vreg[i]; *(LAS u32x4*)(vtww + 8 * i) = sw_; }
            if (tid < 128) Vtw[tid * ML_SV + 64] = f2bf(sc[384 + tid]); }
        __syncthreads();
        {
            const float Mt = sct[256], mold = sc[514];
            bf16x8 af[4];
#pragma unroll
            for (int p = 0; p < 4; ++p) { u32x4 pw;
#pragma unroll
                for (int hf = 0; hf < 2; ++hf) { const int sb = 2 * p + hf; f32x4 sa = (f32x4){0.f, 0.f, 0.f, 0.f};
                    if (sb <= w) {
#pragma unroll
                        for (int kk = 0; kk < 8; ++kk) { const bf16x8 kf = *(const LAS bf16x8*)(ksr + (16 * sb) * 264 + 32 * kk); sa = mfma16(kf, qf[kk], sa); } }
                    float v[4]; const f32x4 g4v = *(const LAS f32x4*)(scq + 16 * sb);
#pragma unroll
                    for (int i = 0; i < 4; ++i) { const int s = 16 * sb + 4 * fq + i; v[i] = (sb <= w && s <= t) ? sa[i] * __expf(g4v[i] - Mt) : 0.f; }
                    pw[2 * hf] = pk_bf16(v[0], v[1]); pw[2 * hf + 1] = pk_bf16(v[2], v[3]); }
                af[p] = __builtin_bit_cast(bf16x8, pw);
                __builtin_amdgcn_sched_barrier(0); }
#define ML_NACC(db, dst) do { dst = (f32x4){0.f, 0.f, 0.f, 0.f}; _Pragma("unroll") for (int p = 0; p < 4; ++p) if (2 * p <= w) { const s16x4 lo = lds_tr4(vtr + (32 * p) * ML_SV + 16 * (db)), hi = lds_tr4(vtr + (32 * p + 16) * ML_SV + 16 * (db)); \
                dst = mfma16((bf16x8){lo[0], lo[1], lo[2], lo[3], hi[0], hi[1], hi[2], hi[3]}, af[p], dst); } } while (0)
#define ML_CACC(db, dst) do { dst = (f32x4){0.f, 0.f, 0.f, 0.f}; _Pragma("unroll") for (int kk = 0; kk < 8; ++kk) { const bf16x8 cf = *(const LAS bf16x8*)(ctr + (16 * (db)) * 264 + 32 * kk); dst = mfma16(cf, qf[kk], dst); } } while (0)
            f32x4 n4, c4; ML_NACC(4, n4); ML_CACC(4, c4);
            const float rowsum = __shfl(n4[0], fr), qn = __shfl(c4[0], fr);
            const float winter = __expf(mold - Mt), den = rowsum + winter * qn, mt = sct[128] + Mt;
            const float inv = 1.0f / fmaxf(fabsf(den), __expf(-mt));
            float ss = 0.f;
#pragma unroll
            for (int db = 0; db < 4; ++db) { f32x4 na, ca; ML_NACC(db, na); ML_CACC(db, ca);
                const f32x4 hv = (na + ca * winter) * inv; ss += (hv[0] * hv[0] + hv[1] * hv[1]) + (hv[2] * hv[2] + hv[3] * hv[3]);
                { u32x2 hw_; hw_.x = pk_bf16(hv[0], hv[1]); hw_.y = pk_bf16(hv[2], hv[3]); *(u32x2*)(ph0 + (size_t)c * 128 * DM * 2 + 32 * db + hoff) = hw_; } }
#undef ML_NACC
#undef ML_CACC
            ss += __shfl_xor(ss, 16); ss += __shfl_xor(ss, 32);
            if (fq == 0 && atom) atomicAdd(ssqA + (tok0 + t) * 4 + h, (u64)(ss * SSQ_SCALE));
        }
        if (w == 0 && c < 15) { float gz[4]; ML_LOAD_G(c + 1); mrun = mlstm_scan(gz[0], gz[1], gz[2], gz[3], ib, fb, lane, sn, mrun); }
        __syncthreads();
        {
            if (c < 15) ML_LOAD_KV(c + 1);
            const float decay = sc[512];
#pragma unroll
            for (int e = 0; e < 2; ++e)
#pragma unroll
                for (int d = 0; d < 5; ++d) Cacc[e][d] = Cacc[e][d] * decay;
#pragma unroll
            for (int p = 0; p < 4; ++p) { bf16x8 vtw[5];
#pragma unroll
                for (int db = 0; db < 5; ++db) { const s16x4 v0 = lds_tr4(vtwr + (32 * p) * ML_SV + 16 * db), v1 = lds_tr4(vtwr + (32 * p + 4) * ML_SV + 16 * db); vtw[db] = (bf16x8){v0[0], v0[1], v0[2], v0[3], v1[0], v1[1], v1[2], v1[3]}; }
#pragma unroll
                for (int eb = 0; eb < 2; ++eb) { const s16x4 k0 = lds_tr4(kgr + (32 * p) * 264 + 16 * eb), k1 = lds_tr4(kgr + (32 * p + 4) * 264 + 16 * eb);
                    const bf16x8 kt = (bf16x8){k0[0], k0[1], k0[2], k0[3], k1[0], k1[1], k1[2], k1[3]};
#pragma unroll
                    for (int db = 0; db < 5; ++db) Cacc[eb][db] = mfma16(vtw[db], kt, Cacc[eb][db]); } }
#pragma unroll
            for (int eb = 0; eb < 2; ++eb) {
#pragma unroll
                for (int db = 0; db < 4; ++db)
#pragma unroll
                    for (int i = 0; i < 4; ++i) ctw[(16 * db + i) * 264 + 16 * eb] = f2bf(Cacc[eb][db][i]);
                if (fq == 0) ctw[64 * 264 + 16 * eb] = f2bf(Cacc[eb][4][0]); }
        }
        __syncthreads();
    }
#undef ML_LOAD_KV
#undef ML_LOAD_G
#pragma unroll
    for (int eb = 0; eb < 2; ++eb) {
#pragma unroll
        for (int db = 0; db < 4; ++db) *(f32x4*)(pC + ((size_t)bh * 256 + 32 * w + 16 * eb + fr) * 512 + 64 * j + 16 * db + 4 * fq) = Cacc[eb][db];
        if (j == 0 && fq == 0) pn[bh * 256 + 32 * w + 16 * eb + fr] = Cacc[eb][4][0]; }
    if (j == 0 && tid == 0) pm[bh] = sbuf[ML_SBN + 513];
    __syncthreads();
}

constexpr int SD_BS = 0, SD_CS = 34816, SD_XT = 69632, SD_XTW = 88064, SD_SB = 106496, SD_SC = 123904, SD_SCN = 388, SD_SX = 72;
DI void ssd_scan(float r0, float r1, float dtb, float Aneg, int lane, LAS float* sb) {
    const float dt0 = softplus_f(r0 + dtb), dt1 = softplus_f(r1 + dtb), a0 = dt0 * Aneg, a1 = dt1 * Aneg;
    float s = a0 + a1;
#pragma unroll
    for (int o = 1; o < 64; o <<= 1) { const float tv = __shfl_up(s, o); if (lane >= o) s += tv; }
    const float b1 = s, b0 = s - a1, bl = __shfl(b1, 63);
    *(LAS f32x2*)(sb + 2 * lane) = (f32x2){b0, b1}; *(LAS f32x2*)(sb + 128 + 2 * lane) = (f32x2){dt0, dt1};
    *(LAS f32x2*)(sb + 256 + 2 * lane) = (f32x2){__expf(bl - b0) * dt0, __expf(bl - b1) * dt1};
    if (lane == 0) sb[384] = __expf(bl);
}
DI void ssd_prompt_unit(LAS unsigned char* lds, int unit, const bf16* proj, const bf16* XA, const float* gsm, const float* dt_bias, const float* A_log, const float* Dsk,
                        bf16* ys, u64* ssqB, float* pS, bool atom) {
    int tid_ = threadIdx.x; asm volatile("" : "+v"(tid_)); const int tid = tid_, lane = tid & 63, w = __builtin_amdgcn_readfirstlane(tid >> 6), fr = lane & 15, fq = lane >> 4;
    const int b = unit >> 5, head = unit & 31, g = head >> 4;
    LAS bf16* Bs = (LAS bf16*)(lds + SD_BS); LAS bf16* Cs = (LAS bf16*)(lds + SD_CS); LAS bf16* Xt = (LAS bf16*)(lds + SD_XT); LAS bf16* Xtw = (LAS bf16*)(lds + SD_XTW); LAS bf16* Sb = (LAS bf16*)(lds + SD_SB);
    LAS float* sbuf = (LAS float*)(lds + SD_SC);
    for (int i = tid; i < 64 * 136 / 2; i += NTHR) ((LAS unsigned*)Sb)[i] = 0u;
    f32x4 Sacc[4];
#pragma unroll
    for (int pb = 0; pb < 4; ++pb) Sacc[pb] = (f32x4){0.f, 0.f, 0.f, 0.f};
    const float dtb = dt_bias[head], Aneg = -__expf(A_log[head]), Dk = Dsk[head];
    const size_t tokb = (size_t)b * SEQ;
    u32x4 breg[4], creg[4], xreg[2];
    const unsigned boff = (unsigned)((tid >> 4) * (XBC * 2) + (tid & 15) * 16), xoff = (unsigned)((tid >> 3) * (XBC * 2) + (tid & 7) * 16);
    const unsigned zoff = (unsigned)((16 * w + fr) * (LDP * 2) + fq * 8), goff = (unsigned)lane * 512u, yoff = (unsigned)((16 * w + fr) * (DM * 2) + fq * 8);
    const char* pb0 = (const char*)(XA + tokb * XBC + 2048 + g * 128); const char* px0 = (const char*)(XA + tokb * XBC + head * 64);
    const char* pz0 = (const char*)(proj + tokb * LDP + PZ + head * 64); const char* pg0 = (const char*)(gsm + tokb * 64 + 8 + head); char* py0 = (char*)(ys + tokb * DM + head * 64);
#define SD_LOAD(c_) do { const size_t cb_ = (size_t)(c_) * 128 * XBC * 2; \
        _Pragma("unroll") for (int i = 0; i < 4; ++i) { const char* rp_ = pb0 + cb_ + (size_t)i * 32 * XBC * 2 + boff; breg[i] = *(const u32x4*)rp_; creg[i] = *(const u32x4*)(rp_ + 512); } \
        _Pragma("unroll") for (int i = 0; i < 2; ++i) xreg[i] = *(const u32x4*)(px0 + cb_ + (size_t)i * 64 * XBC * 2 + xoff); \
        } while (0)
#define SD_LOAD_G(c_) do { const char* gp_ = pg0 + (size_t)(c_) * 128 * 256 + goff; gz[0] = *(const float*)gp_; gz[1] = *(const float*)(gp_ + 256); } while (0)
    SD_LOAD(0);
    if (w == 0) { float gz[2]; SD_LOAD_G(0); ssd_scan(gz[0], gz[1], dtb, Aneg, lane, sbuf); }
    __syncthreads();
    for (int c = 0; c < 16; ++c) {
        const size_t tok0 = tokb + (size_t)c * 128;
        LAS float* sc = sbuf + (c & 1) * SD_SCN; LAS float* sn = sbuf + ((c + 1) & 1) * SD_SCN;
        const int t = 16 * w + fr;
        LAS bf16* bsw = Bs + (tid >> 4) * 136 + 8 * (tid & 15); LAS bf16* xtw_ = Xt + (tid >> 3) * SD_SX + 8 * (tid & 7);
        const LAS bf16* csr = Cs + t * 136 + 8 * fq; const LAS bf16* bsr = Bs + fr * 136 + 8 * fq; const LAS bf16* xtr = Xt + (4 * fq + (fr >> 2)) * SD_SX + 4 * (fr & 3); const LAS bf16* sbr = Sb + fr * 136 + 8 * fq;
        const LAS bf16* xtx = Xt + t * SD_SX + 4 * fq; const LAS bf16* bgr = Bs + (8 * fq + (fr >> 2)) * 136 + 16 * w + 4 * (fr & 3); const LAS bf16* xtwr = Xtw + (8 * fq + (fr >> 2)) * SD_SX + 4 * (fr & 3); LAS bf16* sbw = Sb + fr * 136 + 16 * w + 4 * fq;
        const LAS float* scq = sc + 4 * fq; const LAS float* sct = sc + t; const LAS float* scs = sc + (tid >> 3);
        LAUNDER(bsw); LAUNDER(xtw_); LAUNDER(csr); LAUNDER(bsr); LAUNDER(xtr); LAUNDER(sbr); LAUNDER(xtx); LAUNDER(bgr); LAUNDER(xtwr); LAUNDER(sbw); LAUNDER(scq); LAUNDER(sct); LAUNDER(scs);
#pragma unroll
        for (int i = 0; i < 4; ++i) { *(LAS u32x4*)(bsw + i * 32 * 136) = breg[i]; *(LAS u32x4*)(bsw + (SD_CS - SD_BS) / 2 + i * 32 * 136) = creg[i]; }
#pragma unroll
        for (int i = 0; i < 2; ++i) { const float we = scs[256 + 64 * i];
            u32x4 sw_;
#pragma unroll
            for (int e2 = 0; e2 < 4; ++e2) { const unsigned word = xreg[i][e2]; sw_[e2] = pk_bf16(__uint_as_float(word << 16) * we, __uint_as_float(word & 0xffff0000u) * we); }
            *(LAS u32x4*)(xtw_ + 64 * SD_SX * i) = xreg[i]; *(LAS u32x4*)(xtw_ + (SD_XTW - SD_XT) / 2 + 64 * SD_SX * i) = sw_; }
        const char* zp_ = pz0 + (size_t)c * 128 * LDP * 2 + zoff;
        const u32x2 zr0 = *(const u32x2*)zp_, zr1 = *(const u32x2*)(zp_ + 32), zr2 = *(const u32x2*)(zp_ + 64), zr3 = *(const u32x2*)(zp_ + 96);
        __syncthreads();
        {
            const float bt = sct[0];
            bf16x8 cf[4];
#pragma unroll
            for (int kk = 0; kk < 4; ++kk) cf[kk] = *(const LAS bf16x8*)(csr + 32 * kk);
            bf16x8 af[4];
#pragma unroll
            for (int p = 0; p < 4; ++p) { u32x4 pw;
#pragma unroll
                for (int hf = 0; hf < 2; ++hf) { const int sb = 2 * p + hf; f32x4 sa = (f32x4){0.f, 0.f, 0.f, 0.f};
                    if (sb <= w) {
#pragma unroll
                        for (int kk = 0; kk < 4; ++kk) { const bf16x8 bfg = *(const LAS bf16x8*)(bsr + (16 * sb) * 136 + 32 * kk); sa = mfma16(bfg, cf[kk], sa); } }
                    float v[4]; const f32x4 b4 = *(const LAS f32x4*)(scq + 16 * sb), d4 = *(const LAS f32x4*)(scq + 128 + 16 * sb);
#pragma unroll
                    for (int i = 0; i < 4; ++i) { const int s = 16 * sb + 4 * fq + i; v[i] = (sb <= w && s <= t) ? sa[i] * __expf(bt - b4[i]) * d4[i] : 0.f; }
                    pw[2 * hf] = pk_bf16(v[0], v[1]); pw[2 * hf + 1] = pk_bf16(v[2], v[3]); }
                af[p] = __builtin_bit_cast(bf16x8, pw); }
            const float ebt = __expf(bt);
            float ss = 0.f;
#pragma unroll
            for (int pb = 0; pb < 4; ++pb) { f32x4 yacc = (f32x4){0.f, 0.f, 0.f, 0.f}, y2 = yacc;
#pragma unroll
                for (int p = 0; p < 4; ++p) if (2 * p <= w) { const s16x4 lo = lds_tr4(xtr + (32 * p) * SD_SX + 16 * pb), hi = lds_tr4(xtr + (32 * p + 16) * SD_SX + 16 * pb);
                    yacc = mfma16((bf16x8){lo[0], lo[1], lo[2], lo[3], hi[0], hi[1], hi[2], hi[3]}, af[p], yacc); }
#pragma unroll
                for (int kk = 0; kk < 4; ++kk) { const bf16x8 sf = *(const LAS bf16x8*)(sbr + (16 * pb) * 136 + 32 * kk); y2 = mfma16(sf, cf[kk], y2); }
                const u32x2 zr = pb == 0 ? zr0 : (pb == 1 ? zr1 : (pb == 2 ? zr2 : zr3));
                f32x4 o;
                const u32x2 xsk = *(const LAS u32x2*)(xtx + 16 * pb);
#pragma unroll
                for (int i = 0; i < 4; ++i) { const unsigned xw_ = xsk[i >> 1]; const float xv = (i & 1) ? __uint_as_float(xw_ & 0xffff0000u) : __uint_as_float(xw_ << 16); const unsigned zw = zr[i >> 1]; const float z = (i & 1) ? __uint_as_float(zw & 0xffff0000u) : __uint_as_float(zw << 16);
                    const float y = yacc[i] + ebt * y2[i] + Dk * xv; o[i] = y * silu_f(z); ss += o[i] * o[i]; }
                { u32x2 ow_; ow_.x = pk_bf16(o[0], o[1]); ow_.y = pk_bf16(o[2], o[3]); *(u32x2*)(py0 + (size_t)c * 128 * DM * 2 + 32 * pb + yoff) = ow_; } }
            ss += __shfl_xor(ss, 16); ss += __shfl_xor(ss, 32);
            if (fq == 0 && atom) atomicAdd(ssqB + (tok0 + t) * 2 + g, (u64)(ss * SSQ_SCALE));
        }
        if (w == 0 && c < 15) { float gz[2]; SD_LOAD_G(c + 1); ssd_scan(gz[0], gz[1], dtb, Aneg, lane, sn); }
        __syncthreads();
        {
            if (c < 15) SD_LOAD(c + 1);
            const float eb = sc[384];
#pragma unroll
            for (int pb = 0; pb < 4; ++pb) Sacc[pb] = Sacc[pb] * eb;
#pragma unroll
            for (int p = 0; p < 4; ++p) { const s16x4 b0 = lds_tr4(bgr + (32 * p) * 136), b1 = lds_tr4(bgr + (32 * p + 4) * 136);
                const bf16x8 btf = (bf16x8){b0[0], b0[1], b0[2], b0[3], b1[0], b1[1], b1[2], b1[3]};
#pragma unroll
                for (int pb = 0; pb < 4; ++pb) { const s16x4 x0 = lds_tr4(xtwr + (32 * p) * SD_SX + 16 * pb), x1 = lds_tr4(xtwr + (32 * p + 4) * SD_SX + 16 * pb);
                    Sacc[pb] = mfma16(btf, (bf16x8){x0[0], x0[1], x0[2], x0[3], x1[0], x1[1], x1[2], x1[3]}, Sacc[pb]); } }
#pragma unroll
            for (int pb = 0; pb < 4; ++pb) { u32x2 o; o.x = pk_bf16(Sacc[pb][0], Sacc[pb][1]); o.y = pk_bf16(Sacc[pb][2], Sacc[pb][3]); *(LAS u32x2*)(sbw + (16 * pb) * 136) = o; }
        }
        __syncthreads();
    }
#undef SD_LOAD
#undef SD_LOAD_G
#pragma unroll
    for (int pb = 0; pb < 4; ++pb) *(f32x4*)(pS + (((size_t)b * 32 + head) * 64 + 16 * pb + fr) * 128 + 16 * w + 4 * fq) = Sacc[pb];
    __syncthreads();
}

DI void mlstm_decode_unit(LAS unsigned char* lds, int unit, const bf16* proj, const float* gsm, const float* i_bias, const float* f_bias,
                          const float* stC, const float* stn, const float* stm, bf16* hml, u64* ssqA, float* sC, float* sn, float* sm, bool atom) {
    int tid_ = threadIdx.x; asm volatile("" : "+v"(tid_)); const int tid = tid_, lane = tid & 63, w = __builtin_amdgcn_readfirstlane(tid >> 6);
    const int bs = unit >> 2, h = unit & 3; const size_t R = (size_t)NPROMPT + bs;
    LAS float* qs = (LAS float*)lds; LAS float* ks = qs + 256; LAS float* vs = ks + 256; LAS float* ns = vs + 512; LAS float* red = ns + 256; LAS f32x4* red4 = (LAS f32x4*)(red + 64);
    if (tid < 256) { qs[tid] = bf2f(proj[R * LDP + PQ + h * 256 + tid]); ks[tid] = bf2f(proj[R * LDP + PK + h * 256 + tid]); ns[tid] = stn[(size_t)unit * 256 + tid]; }
    vs[tid] = bf2f(proj[R * LDP + PV + h * 512 + tid]);
    __syncthreads();
    { float pqk = 0.f, pqn = 0.f; if (tid < 256) { pqk = qs[tid] * ks[tid]; pqn = qs[tid] * ns[tid]; }
      pqk = wave_sum(pqk); pqn = wave_sum(pqn); if (lane == 0) { red[w] = pqk; red[8 + w] = pqn; } }
    __syncthreads();
    const float qk = (red[0] + red[1]) + (red[2] + red[3]), qn = (red[8] + red[9]) + (red[10] + red[11]);
    const float li = gsm[R * 64 + h] + i_bias[h], lf = log_sigmoid(gsm[R * 64 + 4 + h] + f_bias[h]), m0 = stm[unit];
    const float mt = fmaxf(lf + m0, li), wi = __expf(li - mt), wo = __expf(lf + m0 - mt);
    const float sv = qk * wi, den = sv + wo * qn, inv = 1.0f / fmaxf(fabsf(den), __expf(-mt));
    const int col4 = tid & 127, dg = tid >> 7;
    const f32x4* Cin = (const f32x4*)(stC + (size_t)unit * 131072); f32x4* Cout = (f32x4*)(sC + (size_t)unit * 131072);
    const f32x4 v4 = *(const LAS f32x4*)(vs + 4 * col4);
    f32x4 acc = (f32x4){0.f, 0.f, 0.f, 0.f};
#pragma unroll 1
    for (int it = 0; it < 64; it += 8) { f32x4 cv[8];
#pragma unroll
        for (int u = 0; u < 8; ++u) cv[u] = __builtin_nontemporal_load(Cin + (size_t)(4 * (it + u) + dg) * 128 + col4);
#pragma unroll
        for (int u = 0; u < 8; ++u) { const int d = 4 * (it + u) + dg; const float qd = qs[d], kd = ks[d] * wi; acc += cv[u] * qd;
            __builtin_nontemporal_store(cv[u] * wo + v4 * kd, Cout + (size_t)d * 128 + col4); } }
    red4[dg * 128 + col4] = acc;
    __syncthreads();
    float ss = 0.f;
    if (dg == 0) { const f32x4 tot = (red4[col4] + red4[128 + col4]) + (red4[256 + col4] + red4[384 + col4]);
        const f32x4 hv = (v4 * sv + tot * wo) * inv; ss = (hv[0] * hv[0] + hv[1] * hv[1]) + (hv[2] * hv[2] + hv[3] * hv[3]);
        { u32x2 hw_; hw_.x = pk_bf16(hv[0], hv[1]); hw_.y = pk_bf16(hv[2], hv[3]); *(u32x2*)(hml + R * DM + h * 512 + 4 * col4) = hw_; } }
    ss = wave_sum(ss);
    if (lane == 0 && w < 2 && atom) atomicAdd(ssqA + R * 4 + h, (u64)(ss * SSQ_SCALE));
    if (tid < 256) sn[(size_t)unit * 256 + tid] = wo * ns[tid] + wi * ks[tid];
    if (tid == 0) sm[unit] = mt;
    __syncthreads();
}
DI void ssd_decode_unit(LAS unsigned char* lds, int unit, const bf16* proj, const bf16* XA, const float* gsm, const float* dt_bias, const float* A_log, const float* Dsk,
                        const float* stS, bf16* ys, u64* ssqB, float* sS, bool atom) {
    int tid_ = threadIdx.x; asm volatile("" : "+v"(tid_)); const int tid = tid_, lane = tid & 63, w = __builtin_amdgcn_readfirstlane(tid >> 6);
    const int bs = unit >> 2, head = 8 * (unit & 3) + w, g = head >> 4; const size_t R = (size_t)NPROMPT + bs;
    LAS float* xs = (LAS float*)(lds + w * 2048); LAS float* Bv = xs + 64; LAS float* Cv = Bv + 128;
    const bf16* xr = XA + R * XBC;
    xs[lane] = bf2f(xr[head * 64 + lane]);
    Bv[lane] = bf2f(xr[2048 + g * 128 + lane]); Bv[lane + 64] = bf2f(xr[2048 + g * 128 + 64 + lane]);
    Cv[lane] = bf2f(xr[2304 + g * 128 + lane]); Cv[lane + 64] = bf2f(xr[2304 + g * 128 + 64 + lane]);
    asm volatile("s_waitcnt lgkmcnt(0)" ::: "memory");
    const float cbdot = wave_sum(Cv[lane] * Bv[lane] + Cv[lane + 64] * Bv[lane + 64]);
    const float dt = softplus_f(gsm[R * 64 + 8 + head] + dt_bias[head]), ea = __expf(-dt * __expf(A_log[head])), Dk = Dsk[head];
    const int n4 = lane & 31, prow = lane >> 5;
    const f32x4 B4 = *(const LAS f32x4*)(Bv + 4 * n4), C4 = *(const LAS f32x4*)(Cv + 4 * n4);
    const f32x4* Sin = (const f32x4*)(stS + ((size_t)bs * 32 + head) * 8192); f32x4* Sout = (f32x4*)(sS + ((size_t)bs * 32 + head) * 8192);
    float ss = 0.f;
#pragma unroll 1
    for (int it = 0; it < 32; it += 8) { f32x4 sv[8];
#pragma unroll
        for (int u = 0; u < 8; ++u) sv[u] = __builtin_nontemporal_load(Sin + (size_t)(2 * (it + u) + prow) * 32 + n4);
#pragma unroll
        for (int u = 0; u < 8; ++u) { const int p = 2 * (it + u) + prow; const float xp = xs[p];
            __builtin_nontemporal_store(sv[u] * ea + B4 * (dt * xp), Sout + (size_t)p * 32 + n4);
            float y2 = (C4[0] * sv[u][0] + C4[1] * sv[u][1]) + (C4[2] * sv[u][2] + C4[3] * sv[u][3]);
#pragma unroll
            for (int o = 1; o < 32; o <<= 1) y2 += __shfl_xor(y2, o);
            const float z = bf2f(proj[R * LDP + PZ + head * 64 + p]);
            const float yv = (cbdot * dt * xp + ea * y2 + Dk * xp) * silu_f(z);
            if (n4 == 0) { ys[R * DM + head * 64 + p] = f2bf(yv); ss += yv * yv; } } }
    ss += __shfl_xor(ss, 32);
    if (lane == 0 && atom) atomicAdd(ssqB + R * 2 + g, (u64)(ss * SSQ_SCALE));
}

DI void merge_phase(const Args& a, int vcu, int G) {
    int tid_ = threadIdx.x; asm volatile("" : "+v"(tid_)); const int tid = tid_, lane = tid & 63, wave = __builtin_amdgcn_readfirstlane(tid >> 6);
    unsigned char* ws = a.ws;
    const bf16* proj = (const bf16*)(ws + WS_PROJ); const bf16* hml = (const bf16*)(ws + WS_HML); const bf16* ys = (const bf16*)(ws + WS_YS);
    const u64* ssqA = (const u64*)(ws + WS_SSQ) + SSQA; const u64* ssqB = (const u64*)(ws + WS_SSQ) + SSQB;
    bf16* mg = (bf16*)(ws + WS_MERGED); const float* hnw = a.in[15]; const float* snw = a.in[21];
    const int gw = vcu * NWAVES + wave, NGW = G * NWAVES;
    for (int row = gw; row < NTOK; row += NGW) {
        float rA[4], rB[2];
#pragma unroll
        for (int i = 0; i < 4; ++i) rA[i] = rs_from(ssqA, row * 4 + i, 1.0f / 512.0f);
#pragma unroll
        for (int i = 0; i < 2; ++i) rB[i] = rs_from(ssqB, row * 2 + i, 1.0f / 1024.0f);
#pragma unroll
        for (int it = 0; it < 8; ++it) { const int c = 4 * lane + 256 * it;
            const u32x2 hr = *(const u32x2*)(hml + (size_t)row * DM + c), yr = *(const u32x2*)(ys + (size_t)row * DM + c); const f32x4 hw = *(const f32x4*)(hnw + c), sw = *(const f32x4*)(snw + c);
            const f32x4 hv = (f32x4){__uint_as_float(hr.x << 16), __uint_as_float(hr.x & 0xffff0000u), __uint_as_float(hr.y << 16), __uint_as_float(hr.y & 0xffff0000u)}, yv = (f32x4){__uint_as_float(yr.x << 16), __uint_as_float(yr.x & 0xffff0000u), __uint_as_float(yr.y << 16), __uint_as_float(yr.y & 0xffff0000u)};
            const u32x2 og = *(const u32x2*)(proj + (size_t)row * LDP + POG + c), ga = *(const u32x2*)(proj + (size_t)row * LDP + PGATE + c), gb = *(const u32x2*)(proj + (size_t)row * LDP + PGATE + DM + c);
            float o[4];
#pragma unroll
            for (int i = 0; i < 4; ++i) { const unsigned ow = og[i >> 1], aw = ga[i >> 1], bw = gb[i >> 1];
                const float ogf = (i & 1) ? __uint_as_float(ow & 0xffff0000u) : __uint_as_float(ow << 16), gaf = (i & 1) ? __uint_as_float(aw & 0xffff0000u) : __uint_as_float(aw << 16), gbf = (i & 1) ? __uint_as_float(bw & 0xffff0000u) : __uint_as_float(bw << 16);
                o[i] = sigm_f(gaf) * (sigm_f(ogf) * hv[i] * rA[it >> 1] * hw[i]) + sigm_f(gbf) * (yv[i] * rB[it >> 2] * sw[i]); }
            u32x2 wv; wv.x = pk_bf16(o[0], o[1]); wv.y = pk_bf16(o[2], o[3]); *(u32x2*)(mg + (size_t)row * DM + c) = wv; }
    }
    float* out = a.out; const int gt = vcu * NTHR + tid, NGT = G * NTHR;
    for (int i = gt; i < NBATCH * 3 * XBC; i += NGT) { const int ch = i % XBC, r = (i / XBC) % 3, b = i / (3 * XBC); out[O_PCONV + i] = bf2f(proj[((size_t)b * SEQ + SEQ - 3 + r) * LDP + PXBC + ch]); }
    const float* stc = a.in[2];
    for (int i = gt; i < NSAMP * 3 * XBC; i += NGT) { const int ch = i % XBC, r = (i / XBC) % 3, bs = i / (3 * XBC);
        out[O_SCONV + i] = r < 2 ? stc[(size_t)bs * 3 * XBC + (r + 1) * XBC + ch] : bf2f(proj[((size_t)NPROMPT + bs) * LDP + PXBC + ch]); }
}
DI void final_norm_phase(const Args& a, int vcu, int G) {
    int tid_ = threadIdx.x; asm volatile("" : "+v"(tid_)); const int tid = tid_, lane = tid & 63, wave = __builtin_amdgcn_readfirstlane(tid >> 6);
    const u64* ssq3 = (const u64*)(a.ws + WS_SSQ) + SSQ3; const float* fw = a.in[27]; float* out = a.out; const bf16* xb = (const bf16*)(a.ws + WS_XB);
    const int gw = vcu * NWAVES + wave, NGW = G * NWAVES;
    for (int row = gw; row < NTOK; row += NGW) { const float r = rs_from(ssq3, row, 1.0f / 2048.0f);
#pragma unroll
        for (int it = 0; it < 4; ++it) { const int c = 8 * lane + 512 * it; const u32x4 xr = *(const u32x4*)(xb + (size_t)row * DM + c);
            const f32x4 f0 = *(const f32x4*)(fw + c), f1 = *(const f32x4*)(fw + c + 4);
            const f32x4 v0 = (f32x4){__uint_as_float(xr.x << 16), __uint_as_float(xr.x & 0xffff0000u), __uint_as_float(xr.y << 16), __uint_as_float(xr.y & 0xffff0000u)};
            const f32x4 v1 = (f32x4){__uint_as_float(xr.z << 16), __uint_as_float(xr.z & 0xffff0000u), __uint_as_float(xr.w << 16), __uint_as_float(xr.w & 0xffff0000u)};
            *(f32x4*)(out + (size_t)row * DM + c) = v0 * r * f0; *(f32x4*)(out + (size_t)row * DM + c + 4) = v1 * r * f1; } }
}

template <int KSTEPS>
DI void gemm_skinny(LAS unsigned char* lds, int c, const bf16* A, const bf16* Bt, const float* res, const bf16* resb, float alpha, float* out, bf16* xb, u64* ssq) {
    int tid_ = threadIdx.x; asm volatile("" : "+v"(tid_)); const int tid = tid_, lane = tid & 63, w = __builtin_amdgcn_readfirstlane(tid >> 6), fr = lane & 15, fq = lane >> 4;
    constexpr int K = KSTEPS * 256, kw = K / 8;
    const int cb = c >> 1, r0 = 64 * (c & 1);
    const bf16* ap = A + (size_t)(NPROMPT + r0 + fr) * K + w * kw + 8 * fq;
    const bf16* bp = Bt + (size_t)(16 * cb + fr) * K + w * kw + 8 * fq;
    f32x4 acc[4];
#pragma unroll
    for (int rb = 0; rb < 4; ++rb) acc[rb] = (f32x4){0.f, 0.f, 0.f, 0.f};
#pragma unroll
    for (int k0 = 0; k0 < KSTEPS; k0 += 4) { bf16x8 bfg[4], af[4][4];
#pragma unroll
        for (int u = 0; u < 4; ++u) if (k0 + u < KSTEPS) { bfg[u] = *(const bf16x8*)(bp + 32 * (k0 + u));
#pragma unroll
            for (int rb = 0; rb < 4; ++rb) af[u][rb] = *(const bf16x8*)(ap + (size_t)rb * 16 * K + 32 * (k0 + u)); }
#pragma unroll
        for (int u = 0; u < 4; ++u) if (k0 + u < KSTEPS) {
#pragma unroll
            for (int rb = 0; rb < 4; ++rb) acc[rb] = mfma16(bfg[u], af[u][rb], acc[rb]); } }
    LAS f32x4* red = (LAS f32x4*)lds;
#pragma unroll
    for (int rb = 0; rb < 4; ++rb) red[(w * 4 + rb) * 64 + lane] = acc[rb];
    __syncthreads();
    if (w < 4) {
        f32x4 sum = red[w * 64 + lane];
#pragma unroll
        for (int w2 = 1; w2 < 8; ++w2) sum += red[(w2 * 4 + w) * 64 + lane];
        const int rl = r0 + 16 * w + fr, col = 16 * cb + 4 * fq;
        f32x4 rv;
        if (res) rv = *(const f32x4*)(res + (size_t)rl * DM + col);
        else { const u32x2 rw = *(const u32x2*)(resb + (size_t)(NPROMPT + rl) * DM + col); rv = (f32x4){__uint_as_float(rw.x << 16), __uint_as_float(rw.x & 0xffff0000u), __uint_as_float(rw.y << 16), __uint_as_float(rw.y & 0xffff0000u)}; }
        const f32x4 o = rv + sum * alpha;
        if (out) *(f32x4*)(out + (size_t)rl * DM + col) = o;
        if (xb) { u32x2 wv; wv.x = pk_bf16(o[0], o[1]); wv.y = pk_bf16(o[2], o[3]); *(u32x2*)(xb + (size_t)(NPROMPT + rl) * DM + col) = wv; }
        float ss = (o[0] * o[0] + o[1] * o[1]) + (o[2] * o[2] + o[3] * o[3]);
        ss += __shfl_xor(ss, 16); ss += __shfl_xor(ss, 32);
        if (fq == 0) atomicAdd(ssq + NPROMPT + rl, (u64)(ss * SSQ_SCALE));
    }
    __syncthreads();
}

#define XB_TMO      128
#define XB_XCNT(j)  (256  + 64 * (j))
#define XB_XSUB(j)  (1280 + 64 * (j))
#define XB_XGEN(j)  (2304 + 64 * (j))
#define XB_TOP      3328
#define XB_TOPGEN   3392
#define XCD_BAR_WORDS 3456
#define XB_SPIN_CAP (1u << 18)

__device__ __forceinline__ unsigned xb_ld(unsigned* p)              { return __hip_atomic_load(p, __ATOMIC_RELAXED, __HIP_MEMORY_SCOPE_AGENT); }
__device__ __forceinline__ unsigned xb_add(unsigned* p, unsigned v) { return __hip_atomic_fetch_add(p, v, __ATOMIC_RELAXED, __HIP_MEMORY_SCOPE_AGENT); }
__device__ __forceinline__ unsigned xb_xcc_id() { return (unsigned)__builtin_amdgcn_s_getreg((3 << 11) | 20) & 0xFu; }
#define XB_SPIN(cond, bar) do { unsigned _sp = 0; while (cond) { __builtin_amdgcn_s_sleep(1); \
    if ((++_sp & 255u) == 0u) { if (xb_ld(&(bar)[XB_TMO])) break; if (_sp > XB_SPIN_CAP) { atomicAdd(&(bar)[XB_TMO], 1u); break; } } } } while (0)

struct XcdBarrier {
    unsigned* bar; unsigned x;
    volatile LAS unsigned* st;
};

__device__ __forceinline__ XcdBarrier xcd_barrier_post(unsigned* bar, volatile LAS unsigned* st) {
    XcdBarrier b; b.bar = bar; b.x = xb_xcc_id(); b.st = st;
    if (threadIdx.x == 0) (void)xb_add(&bar[XB_XCNT(b.x)], 1u);
    return b;
}
__device__ __forceinline__ void xcd_barrier_complete(unsigned* bar, unsigned x, unsigned& nloc, unsigned& nx) {
    const unsigned G = gridDim.x * gridDim.y * gridDim.z;
    unsigned sum, cnt, mine, sp = 0u;
    for (;;) {
        sum = 0u; cnt = 0u; mine = 0u;
#pragma unroll
        for (unsigned j = 0; j < 16; ++j) { const unsigned c = xb_ld(&bar[XB_XCNT(j)]); sum += c; cnt += (c > 0u) ? 1u : 0u; mine = (j == x) ? c : mine; }
        if (sum == G) break;
        __builtin_amdgcn_s_sleep(1);
        if ((++sp & 255u) == 0u) { if (xb_ld(&bar[XB_TMO])) break; if (sp > XB_SPIN_CAP) { atomicAdd(&bar[XB_TMO], 1u); break; } }
    }
    nloc = mine > 0u ? mine : 1u; nx = cnt > 0u ? cnt : 1u;
}

__device__ __forceinline__ void xcd_barrier(const XcdBarrier& b) {
    asm volatile("s_waitcnt vmcnt(0)" ::: "memory");
    __syncthreads();
    if (threadIdx.x == 0) {
        unsigned* bar = b.bar;
        __builtin_amdgcn_s_waitcnt(0);
        unsigned nloc = b.st[0], nx = b.st[1];
        if (nloc == 0u) { xcd_barrier_complete(bar, b.x, nloc, nx); b.st[0] = nloc; b.st[1] = nx; }
        const unsigned old = xb_add(&bar[XB_XSUB(b.x)], 1u);
        const unsigned gen = old / nloc;
        if (old + 1u == (gen + 1u) * nloc) {
            __builtin_amdgcn_fence(__ATOMIC_RELEASE, "agent");
            asm volatile("s_waitcnt vmcnt(0)" ::: "memory");
            const unsigned og = xb_add(&bar[XB_TOP], 1u);
            const unsigned tg = og / nx;
            if (og + 1u == (tg + 1u) * nx) xb_add(&bar[XB_TOPGEN], 1u);
            else XB_SPIN(xb_ld(&bar[XB_TOPGEN]) == tg, bar);
            __builtin_amdgcn_fence(__ATOMIC_ACQUIRE, "agent");
            xb_add(&bar[XB_XGEN(b.x)], 1u);
            asm volatile("s_waitcnt vmcnt(0)" ::: "memory");
        } else {
            XB_SPIN(xb_ld(&bar[XB_XGEN(b.x)]) == gen, bar);
            __builtin_amdgcn_fence(__ATOMIC_ACQUIRE, "agent");
            asm volatile("s_waitcnt vmcnt(0)" ::: "memory");
        }
    }
    __syncthreads();
}


__global__ void __launch_bounds__(NTHR, 2) hybrid_fwd(Args a) {
    extern __shared__ __attribute__((aligned(16))) unsigned char lds_raw[];
    LAS unsigned char* lds = (LAS unsigned char*)lds_raw;
    cg::grid_group grid = cg::this_grid();
    const int G = gridDim.x, bx = blockIdx.x;
    const int vcu = (G % 8 == 0) ? (bx % 8) * (G / 8) + bx / 8 : bx;
    unsigned char* ws = a.ws;
    volatile LAS unsigned* bst = (volatile LAS unsigned*)(lds + LDS_BYTES - 16);
    if (threadIdx.x < 4) bst[threadIdx.x] = 0u;
    __syncthreads();
    XcdBarrier xbar = xcd_barrier_post((unsigned*)(ws + WS_BAR), bst);
    u64* ssq = (u64*)(ws + WS_SSQ);
    bf16* xb = (bf16*)(ws + WS_XB); bf16* Hb = (bf16*)(ws + WS_H); bf16* proj = (bf16*)(ws + WS_PROJ); bf16* mg = (bf16*)(ws + WS_MERGED);
    float* gsm = (float*)(ws + WS_GSM); bf16* hml = (bf16*)(ws + WS_HML); bf16* ysb = (bf16*)(ws + WS_YS);

    if (a.out == nullptr) grid.sync();
    p0_prologue(lds, a, vcu, G);
    xcd_barrier(xbar);
    {
        pg8::Gemm g{xb, (const bf16*)(ws + WS_WGU1), MP, NGU, DM}; pg8::StaticOrder S; S.init(MP, NGU, G, bx);
        pg8::EpiSwiGLU E{Hb, FF, ssq + SSQ0};
        pg8::gemm_phase<pg8::EpiSwiGLU, pg8::StaticOrder, true, true>(lds, g, S, E);
        { const int nfull = (MP / 256) * (NGU / 256) % G;
          if (nfull && bx >= nfull) convert_items(lds, a, CV_PROLOGUE_END, CV_G1TAIL_END, (bx - nfull) * NWAVES + __builtin_amdgcn_readfirstlane((int)(threadIdx.x >> 6)), (G - nfull) * NWAVES); }
    }
    xcd_barrier(xbar);
    {
        pg8::Gemm g{Hb, (const bf16*)(ws + WS_WD1), NPROMPT, DM, FF}; pg8::StaticOrder S; S.init(NPROMPT, DM, G, bx);
        pg8::EpiResid E{nullptr, xb, nullptr, xb, ssq + SSQ1, 0.5f};
        pg8::gemm_phase<pg8::EpiResid, pg8::StaticOrder, true, true>(lds, g, S, E);
        for (int c = vcu; c < 256; c += G) gemm_skinny<FF / 256>(lds, c, Hb, (const bf16*)(ws + WS_WD1), nullptr, xb, 0.5f, nullptr, xb, ssq + SSQ1);
    }
    xcd_barrier(xbar);
    {
        pg8::Gemm g{xb, (const bf16*)(ws + WS_WIN), MP, NPROJ, DM}; pg8::StaticOrder S; S.init(MP, NPROJ, G, bx);
        pg8::EpiProj E{proj, LDP, gsm, ssq + SSQ1, LDP / 256};
        pg8::gemm_phase<pg8::EpiProj, pg8::StaticOrder, true, true>(lds, g, S, E);
        { const int nfull = (MP / 256) * (NPROJ / 256) % G;
          if (nfull && bx >= nfull) convert_items(lds, a, CV_G1TAIL_END, CV_END, (bx - nfull) * NWAVES + __builtin_amdgcn_readfirstlane((int)(threadIdx.x >> 6)), (G - nfull) * NWAVES); }
    }
    xcd_barrier(xbar);
    {
        float* out = a.out; const bf16* XA = (const bf16*)(ws + WS_XA);
        unsigned* qctr = (unsigned*)(ws + WS_BAR) + XCD_BAR_WORDS;
        const bool split = (G == 256);
        bool conv_seen = !split;
        if (!split) { conv_pass(a, vcu, G); xcd_barrier(xbar); }
        else if (vcu >= 128) {
            conv_pass(a, vcu - 128, 128);
            asm volatile("s_waitcnt vmcnt(0)" ::: "memory"); __syncthreads();
            if (threadIdx.x == 0) { __builtin_amdgcn_fence(__ATOMIC_RELEASE, "agent"); asm volatile("s_waitcnt vmcnt(0)" ::: "memory");
                __hip_atomic_fetch_add(qctr + 32, 1u, __ATOMIC_RELAXED, __HIP_MEMORY_SCOPE_AGENT); }
        }
#define WAIT_CONV() do { if (!conv_seen) { if (threadIdx.x == 0) { unsigned sp_ = 0u; \
            while (__hip_atomic_load(qctr + 32, __ATOMIC_RELAXED, __HIP_MEMORY_SCOPE_AGENT) < 128u) { __builtin_amdgcn_s_sleep(2); if (++sp_ > (1u << 22)) break; } \
            __builtin_amdgcn_fence(__ATOMIC_ACQUIRE, "agent"); asm volatile("s_waitcnt vmcnt(0)" ::: "memory"); } \
            __syncthreads(); conv_seen = true; } } while (0)
        for (int u = vcu; u < 256; u += G) {
            if (u < 128) mlstm_prompt_unit(lds, u, proj, gsm, a.in[13], a.in[14], hml, ssq + SSQA, out + O_PC, out + O_PN, out + O_PM, true);
            else { WAIT_CONV(); ssd_prompt_unit(lds, u - 128, proj, XA, gsm, a.in[18], a.in[19], a.in[20], ysb, ssq + SSQB, out + O_PSSM, true); } }
        for (;;) {
            if (threadIdx.x == 0) bst[2] = atomicAdd(qctr, 1u);
            __syncthreads();
            const int u = (int)bst[2];
            __syncthreads();
            if (u >= 1024) break;
            if (u < 512) mlstm_decode_unit(lds, u, proj, gsm, a.in[13], a.in[14], a.in[3], a.in[4], a.in[5], hml, ssq + SSQA, out + O_SC, out + O_SN, out + O_SM, true);
            else { WAIT_CONV(); ssd_decode_unit(lds, u - 512, proj, XA, gsm, a.in[18], a.in[19], a.in[20], a.in[6], ysb, ssq + SSQB, out + O_SSSM, true); }
        }
#undef WAIT_CONV
    }
    xcd_barrier(xbar);
    merge_phase(a, vcu, G);
    xcd_barrier(xbar);
    {
        pg8::Gemm g{mg, (const bf16*)(ws + WS_WOUT), NPROMPT, DM, DM}; pg8::StaticOrder S; S.init(NPROMPT, DM, G, bx);
        pg8::EpiResid E{nullptr, xb, nullptr, xb, ssq + SSQ2, 1.0f};
        pg8::gemm_phase<pg8::EpiResid, pg8::StaticOrder, true, true>(lds, g, S, E);
        for (int c = vcu; c < 256; c += G) gemm_skinny<DM / 256>(lds, c, mg, (const bf16*)(ws + WS_WOUT), nullptr, xb, 1.0f, nullptr, xb, ssq + SSQ2);
    }
    xcd_barrier(xbar);
    {
        pg8::Gemm g{xb, (const bf16*)(ws + WS_WGU2), MP, NGU, DM}; pg8::StaticOrder S; S.init(MP, NGU, G, bx);
        pg8::EpiSwiGLU E{Hb, FF, ssq + SSQ2};
        pg8::gemm_phase<pg8::EpiSwiGLU, pg8::StaticOrder, true, true>(lds, g, S, E);
    }
    xcd_barrier(xbar);
    {
        pg8::Gemm g{Hb, (const bf16*)(ws + WS_WD2), NPROMPT, DM, FF}; pg8::StaticOrder S; S.init(NPROMPT, DM, G, bx);
        pg8::EpiResid E{nullptr, xb, nullptr, xb, ssq + SSQ3, 0.5f};
        pg8::gemm_phase<pg8::EpiResid, pg8::StaticOrder, true, true>(lds, g, S, E);
        for (int c = vcu; c < 256; c += G) gemm_skinny<FF / 256>(lds, c, Hb, (const bf16*)(ws + WS_WD2), nullptr, xb, 0.5f, nullptr, xb, ssq + SSQ3);
    }
    xcd_barrier(xbar);
    final_norm_phase(a, vcu, G);
}

extern "C" void kernel_launch(void* const* d_in, const int* in_sizes, int n_in, void* d_out, int out_size, void* d_ws, size_t ws_size, hipStream_t stream) {
    static int grid = 0;
    if (grid == 0) {
        if (n_in != 28 || ws_size < WS_END) { fprintf(stderr, "kernel_launch: unexpected inputs (n_in %d, ws %zu)\n", n_in, ws_size); grid = -1; return; }
        int dev = 0, cus = 0, per_cu = 0;
        hipGetDevice(&dev); hipDeviceGetAttribute(&cus, hipDeviceAttributeMultiprocessorCount, dev);
        if (hipFuncSetAttribute((const void*)hybrid_fwd, hipFuncAttributeMaxDynamicSharedMemorySize, LDS_BYTES) != hipSuccess) { fprintf(stderr, "kernel_launch: hipFuncSetAttribute failed\n"); grid = -1; return; }
        if (hipOccupancyMaxActiveBlocksPerMultiprocessor(&per_cu, (const void*)hybrid_fwd, NTHR, LDS_BYTES) != hipSuccess || per_cu < 1) { fprintf(stderr, "kernel_launch: occupancy query gave %d\n", per_cu); per_cu = 1; }
        (void)hipGetLastError();
        grid = cus * per_cu;
    }
    if (grid < 0) return;
    Args a{};
    for (int i = 0; i < 28; ++i) a.in[i] = (const float*)d_in[i];
    a.out = (float*)d_out; a.ws = (unsigned char*)d_ws;
    if (hipMemsetAsync((char*)d_ws + WS_BAR, 0, XCD_BAR_WORDS * 4 + 256, stream) != hipSuccess) { fprintf(stderr, "kernel_launch: memset of barrier words failed\n"); return; }
    void* args[] = {&a};
    hipError_t e = hipLaunchCooperativeKernel((const void*)hybrid_fwd, dim3(grid), dim3(NTHR), args, LDS_BYTES, stream);
    if (e != hipSuccess) fprintf(stderr, "kernel_launch: cooperative launch failed: %s (grid %d)\n", hipGetErrorString(e), grid);
}
```
